# Optimizing an MI355X kernel written in HIP

```python
import math
import jax
import jax.numpy as jnp
from jax import lax
import numpy as np

D_MODEL = 1024
BATCH = 8
SEQ = 8192
DEPTH = 2

N_A_LAYERS = DEPTH // 2
N_B_LAYERS = DEPTH - N_A_LAYERS
N_DENSE_LAYERS = (DEPTH + 1) // 2
N_MOE_LAYERS = DEPTH // 2

HGRN_EXPAND = 128
HGRN_HEADS = D_MODEL // HGRN_EXPAND
HGRN_DK = HGRN_EXPAND
HGRN_DV = D_MODEL // HGRN_HEADS
HGRN_CHUNK = 64

SWA_HEAD_DIM = 64
SWA_Q_HEADS = D_MODEL // SWA_HEAD_DIM
SWA_KV_HEADS = 4
SWA_GROUP = SWA_Q_HEADS // SWA_KV_HEADS
WINDOW = 128

REL_BUCKETS = 32
REL_MAX_DIST = 128

D_FF_DENSE = 2816
N_EXPERTS = 8
TOP_K = 2
D_FF_EXPERT = 3584
MOE_BLOCK = 256

NORM_EPS = 1e-6

kernel_name = 'hybrid_hgrn2_swa_yoco_moe'


def rmsnorm(x, gain):
    xf = x.astype(jnp.float32)
    y = xf * lax.rsqrt(jnp.mean(xf * xf, axis=-1, keepdims=True) + NORM_EPS)
    return (y * gain.astype(jnp.float32)).astype(x.dtype)


def hgrn2_mixer(hn, w_in, lb, g_norm, w_out):
    B, S, _ = hn.shape
    nc = S // HGRN_CHUNK
    proj = hn @ w_in
    q, f_raw, i_in, o_gate = jnp.split(proj, 4, axis=-1)
    lbf = lb.astype(jnp.float32)
    f = lbf + (1.0 - lbf) * jax.nn.sigmoid(f_raw.astype(jnp.float32))
    log_f = jnp.log(f)
    k = 1.0 - f

    def to_chunks(t, d):
        return t.astype(jnp.float32).reshape(B, nc, HGRN_CHUNK, HGRN_HEADS, d).transpose(1, 0, 3, 2, 4)

    qc = to_chunks(q, HGRN_DK)
    kc = to_chunks(k, HGRN_DK)
    vc = to_chunks(i_in, HGRN_DV)
    gc = to_chunks(log_f, HGRN_DK)
    causal = jnp.tril(jnp.ones((HGRN_CHUNK, HGRN_CHUNK), dtype=bool))

    def chunk_step(state, inp):
        qt, kt, vt, gt = inp
        b = jnp.cumsum(gt, axis=2)
        rel = b[:, :, :, None, :] - b[:, :, None, :, :]
        decay = jnp.exp(jnp.where(causal[:, :, None], rel, -jnp.inf))
        scores = jnp.einsum('bhtd,bhsd,bhtsd->bhts', qt, kt, decay)
        o = scores @ vt + jnp.einsum('bhtd,bhde->bhte', qt * jnp.exp(b), state)
        b_last = b[:, :, -1:, :]
        new_state = jnp.exp(b_last[:, :, 0, :])[..., None] * state + jnp.einsum(
            'bhsd,bhse->bhde', kt * jnp.exp(b_last - b), vt)
        return new_state, o

    s0 = jnp.zeros((B, HGRN_HEADS, HGRN_DK, HGRN_DV), jnp.float32)
    _, o = lax.scan(chunk_step, s0, (qc, kc, vc, gc))
    o = o.transpose(1, 0, 3, 2, 4).reshape(B, S, HGRN_HEADS, HGRN_DV)
    o = rmsnorm(o, g_norm).reshape(B, S, HGRN_HEADS * HGRN_DV)
    o = o * jax.nn.silu(o_gate.astype(jnp.float32))
    return o.astype(hn.dtype) @ w_out


def shared_kv(h, kv_norm, kv_w, k_gain):
    B, S, _ = h.shape
    nb = S // WINDOW
    hn = rmsnorm(h, kv_norm)
    kv = hn @ kv_w
    k, v = jnp.split(kv, 2, axis=-1)
    k = rmsnorm(k.reshape(B, S, SWA_KV_HEADS, SWA_HEAD_DIM), k_gain)
    v = v.reshape(B, S, SWA_KV_HEADS, SWA_HEAD_DIM)

    def band(t):
        tp = jnp.pad(t.astype(jnp.float32), ((0, 0), (WINDOW, 0), (0, 0), (0, 0)))
        tb = tp.reshape(B, nb + 1, WINDOW, SWA_KV_HEADS, SWA_HEAD_DIM)
        return jnp.concatenate([tb[:, :-1], tb[:, 1:]], axis=2)

    return band(k), band(v)


def rel_bucket(n):
    max_exact = REL_BUCKETS // 2
    nf = jnp.maximum(n, 1).astype(jnp.float32)
    large = max_exact + (jnp.log(nf / max_exact) / math.log(REL_MAX_DIST / max_exact)
                         * (REL_BUCKETS - max_exact)).astype(jnp.int32)
    large = jnp.minimum(large, REL_BUCKETS - 1)
    return jnp.where(n < max_exact, n, large)


def swa_attention(hn, k_band, v_band, w_q, q_gain, sink, rel_bias, w_o):
    B, S, _ = hn.shape
    nb = S // WINDOW
    q = (hn @ w_q).reshape(B, S, SWA_Q_HEADS, SWA_HEAD_DIM)
    q = rmsnorm(q, q_gain)
    qb = q.astype(jnp.float32).reshape(B, nb, WINDOW, SWA_KV_HEADS, SWA_GROUP, SWA_HEAD_DIM)
    scores = jnp.einsum('bnqkgd,bnskd->bnkgqs', qb, k_band) * (SWA_HEAD_DIM ** -0.5)
    qi = jnp.arange(WINDOW)[:, None]
    kj = jnp.arange(2 * WINDOW)[None, :]
    dist = qi + WINDOW - kj
    in_win = (dist >= 0) & (dist < WINDOW)
    bias = rel_bias.astype(jnp.float32)[rel_bucket(jnp.maximum(dist, 0))]
    bias = bias.transpose(2, 0, 1).reshape(SWA_KV_HEADS, SWA_GROUP, WINDOW, 2 * WINDOW)
    first_ok = (jnp.arange(nb)[:, None] > 0) | (jnp.arange(2 * WINDOW)[None, :] >= WINDOW)
    valid = in_win[None, :, :] & first_ok[:, None, :]
    logits = jnp.where(valid[None, :, None, None], scores + bias, -jnp.inf)
    sink_l = sink.astype(jnp.float32).reshape(SWA_KV_HEADS, SWA_GROUP)[None, None, :, :, None, None]
    m = jnp.maximum(jnp.max(logits, axis=-1, keepdims=True), sink_l)
    p = jnp.exp(logits - m)
    probs = p / (jnp.sum(p, axis=-1, keepdims=True) + jnp.exp(sink_l - m))
    out = jnp.einsum('bnkgqs,bnskd->bnqkgd', probs, v_band).reshape(B, S, SWA_Q_HEADS * SWA_HEAD_DIM)
    return out.astype(hn.dtype) @ w_o


def swiglu(hn, w_gate, w_up, w_down):
    return (jax.nn.silu(hn @ w_gate) * (hn @ w_up)) @ w_down


def moe_swiglu(hn, w_router, w_gate, w_up, w_down):
    B, S, D = hn.shape
    T = B * S
    A = T * TOP_K
    xt = hn.reshape(T, D)
    logits = (xt @ w_router).astype(jnp.float32)
    top_logit, top_idx = lax.top_k(logits, TOP_K)
    gates = jax.nn.softmax(top_logit, axis=-1)
    flat_e = top_idx.reshape(A)
    flat_tok = jnp.repeat(jnp.arange(T, dtype=jnp.int32), TOP_K)
    flat_g = gates.reshape(A)
    order = jnp.argsort(flat_e, stable=True)
    s_e = flat_e[order]
    s_tok = flat_tok[order]
    s_g = flat_g[order]
    counts = jnp.bincount(flat_e, length=N_EXPERTS)
    padded = (counts + MOE_BLOCK - 1) // MOE_BLOCK * MOE_BLOCK
    pad_end = jnp.cumsum(padded)
    pad_start = pad_end - padded
    grp_start = jnp.cumsum(counts) - counts
    dest = pad_start[s_e] + jnp.arange(A) - grp_start[s_e]
    m_pad = A + N_EXPERTS * MOE_BLOCK
    n_blk = m_pad // MOE_BLOCK
    row_tok = jnp.zeros((m_pad,), jnp.int32).at[dest].set(s_tok)
    row_g = jnp.zeros((m_pad,), jnp.float32).at[dest].set(s_g)
    blk_e = jnp.minimum(jnp.searchsorted(pad_end, jnp.arange(n_blk) * MOE_BLOCK, side='right'),
                        N_EXPERTS - 1)
    xs = xt[row_tok].reshape(n_blk, MOE_BLOCK, D)

    def expert_block(args):
        xb, e = args
        hid = jax.nn.silu(xb @ w_gate[e]) * (xb @ w_up[e])
        return hid @ w_down[e]

    yb = lax.map(expert_block, (xs, blk_e)).reshape(m_pad, D)
    y = jnp.zeros((T, D), hn.dtype).at[row_tok].add(
        (yb.astype(jnp.float32) * row_g[:, None]).astype(hn.dtype))
    return y.reshape(B, S, D)


def setup_inputs(seed: int = 0) -> dict:
    key = jax.random.key(seed)
    ks = jax.random.split(key, 24)
    D = D_MODEL
    f32 = jnp.float32

    def w(k, shape, fan_in):
        return jax.random.normal(k, shape, f32) * (fan_in ** -0.5)

    def gain(k, shape):
        return 1.0 + 0.05 * jax.random.normal(k, shape, f32)

    q_width = SWA_Q_HEADS * SWA_HEAD_DIM
    kv_width = 2 * SWA_KV_HEADS * SWA_HEAD_DIM
    return {
        'x': jax.random.normal(ks[0], (BATCH, SEQ, D), f32),
        'hgrn_w_in': w(ks[1], (N_A_LAYERS, D, 4 * D), D),
        'hgrn_lb': 0.1 * jax.random.normal(ks[2], (DEPTH + 1, D), f32),
        'hgrn_gnorm': gain(ks[3], (N_A_LAYERS, HGRN_DV)),
        'hgrn_w_out': w(ks[4], (N_A_LAYERS, D, D), D),
        'swa_w_q': w(ks[5], (N_B_LAYERS, D, q_width), D),
        'swa_q_gain': gain(ks[6], (N_B_LAYERS, SWA_HEAD_DIM)),
        'swa_sink': jax.random.normal(ks[7], (N_B_LAYERS, SWA_Q_HEADS), f32),
        'swa_w_o': w(ks[8], (N_B_LAYERS, q_width, D), q_width),
        'kv_norm': gain(ks[9], (D,)),
        'kv_w': w(ks[10], (D, kv_width), D),
        'k_gain': gain(ks[11], (SWA_HEAD_DIM,)),
        'rel_bias': 0.5 * jax.random.normal(ks[12], (REL_BUCKETS, SWA_Q_HEADS), f32),
        'attn_norm': gain(ks[13], (DEPTH, D)),
        'ffn_norm': gain(ks[14], (DEPTH, D)),
        'ffn_w_gate': w(ks[15], (N_DENSE_LAYERS, D, D_FF_DENSE), D),
        'ffn_w_up': w(ks[16], (N_DENSE_LAYERS, D, D_FF_DENSE), D),
        'ffn_w_down': w(ks[17], (N_DENSE_LAYERS, D_FF_DENSE, D), D_FF_DENSE),
        'moe_router': w(ks[18], (N_MOE_LAYERS, D, N_EXPERTS), D),
        'moe_w_gate': w(ks[19], (N_MOE_LAYERS, N_EXPERTS, D, D_FF_EXPERT), D),
        'moe_w_up': w(ks[20], (N_MOE_LAYERS, N_EXPERTS, D, D_FF_EXPERT), D),
        'moe_w_down': w(ks[21], (N_MOE_LAYERS, N_EXPERTS, D_FF_EXPERT, D), D_FF_EXPERT),
    }


def reference(x, hgrn_w_in, hgrn_lb, hgrn_gnorm, hgrn_w_out, swa_w_q, swa_q_gain, swa_sink,
              swa_w_o, kv_norm, kv_w, k_gain, rel_bias, attn_norm, ffn_norm, ffn_w_gate,
              ffn_w_up, ffn_w_down, moe_router, moe_w_gate, moe_w_up, moe_w_down):
    h = x
    lb_all = jnp.cumsum(jax.nn.softmax(hgrn_lb.astype(jnp.float32), axis=0), axis=0)
    k_band = None
    v_band = None
    for l in range(DEPTH):
        hn = rmsnorm(h, attn_norm[l])
        if l < N_A_LAYERS:
            a = l
            h = h + hgrn2_mixer(hn, hgrn_w_in[a], lb_all[l], hgrn_gnorm[a], hgrn_w_out[a])
        else:
            bi = l - N_A_LAYERS
            h = h + swa_attention(hn, k_band, v_band, swa_w_q[bi], swa_q_gain[bi], swa_sink[bi],
                                  rel_bias, swa_w_o[bi])
        hn = rmsnorm(h, ffn_norm[l])
        if l % 2 == 0:
            h = h + swiglu(hn, ffn_w_gate[l // 2], ffn_w_up[l // 2], ffn_w_down[l // 2])
        else:
            h = h + moe_swiglu(hn, moe_router[l // 2], moe_w_gate[l // 2], moe_w_up[l // 2],
                               moe_w_down[l // 2])
        if l == N_A_LAYERS - 1:
            k_band, v_band = shared_kv(h, kv_norm, kv_w, k_gain)
    return h
```

```cpp
#include <hip/hip_runtime.h>
#include <cstdio>
#include <cstdint>

#define LAS __attribute__((address_space(3)))
#define GAS __attribute__((address_space(1)))
typedef unsigned short bf16_t;
typedef short bf16x8 __attribute__((ext_vector_type(8)));
typedef short s16x4 __attribute__((ext_vector_type(4)));
typedef float f32x4 __attribute__((ext_vector_type(4)));
typedef float f32x2 __attribute__((ext_vector_type(2)));
typedef float f32x16 __attribute__((ext_vector_type(16)));
typedef unsigned u32x4 __attribute__((ext_vector_type(4)));
typedef unsigned u32x2 __attribute__((ext_vector_type(2)));
typedef _Float16 f16x2 __attribute__((ext_vector_type(2)));
typedef GAS unsigned gu32;

constexpr int BATCH = 8, SEQ = 8192, D = 1024, T = BATCH * SEQ;
constexpr int HG_H = 8, HG_DK = 128, CHK = 64, NCHK = SEQ / CHK;
constexpr int FF0 = 2816, NE = 8, FFE = 3584;
constexpr int QH = 16, KVH = 4, HD = 64, WIN = 128;
constexpr float EPS = 1e-6f;
constexpr float LOG2E = 1.4426950408889634f;
constexpr int MPAD = T + NE * 256;
constexpr int MAXRT = MPAD / 256;

constexpr size_t MiB = 1u << 20;
constexpr size_t WS_CTL = 0, CTL_ZERO_BYTES = 4 * MiB;
constexpr size_t WS_ROWSS1 = 1 * MiB, WS_ROWSS2 = WS_ROWSS1 + 512 * 1024, WS_ROWSS3 = WS_ROWSS2 + 512 * 1024;
constexpr size_t WS_LB = 4 * MiB;
constexpr size_t WS_DCH = 5 * MiB;
constexpr size_t WS_LTOK = 9 * MiB, WS_LG = 13 * MiB;
constexpr size_t WS_RTOK = 17 * MiB, WS_RG = 18 * MiB, WS_RRINV = 19 * MiB, WS_TILEE = 20 * MiB;
constexpr size_t WS_WQO = 24 * MiB, WS_WFI = 28 * MiB, WS_WOUT = 32 * MiB, WS_WGU = 34 * MiB, WS_WDN = 45 * MiB, WS_WQK = 51 * MiB, WS_WV = 54 * MiB, WS_WO = 55 * MiB;
constexpr size_t WS_MGU = 57 * MiB, WS_MDN = 169 * MiB;
constexpr size_t WS_R0 = 226 * MiB, WS_R1 = 354 * MiB, WS_R2 = 482 * MiB, WS_R3 = 866 * MiB, WS_END = 994 * MiB;
constexpr size_t WS_XN = WS_R0, WS_OGATED = WS_R0, WS_H2 = WS_R0;
constexpr size_t WS_Q1 = WS_R1, WS_H1 = WS_R1, WS_AO = WS_R1, WS_HIDM = WS_R1;
constexpr size_t WS_GT = WS_R2, WS_VT = WS_R2 + 128 * MiB, WS_OG1 = WS_R2 + 256 * MiB, WS_HID0 = WS_R2;
constexpr size_t WS_Q2 = WS_R2, WS_K2 = WS_R2 + 128 * MiB, WS_VT2 = WS_R2 + 160 * MiB;
constexpr size_t WS_OINTRA = WS_R3;
static_assert(WS_HIDM + (size_t)MPAD * FFE * 2 <= WS_END, "HIDM fits");
static_assert(WS_HID0 + (size_t)T * FF0 * 2 <= WS_R3, "HID0 fits");
constexpr int CW_BAR = 4096;
constexpr int CW_MCNT = 16384;

constexpr int RING_BYTES = 131072;
constexpr int MISC_OFF = RING_BYTES + 320;
constexpr int LDS_BYTES = 147456;

#define LDS_WAIT() asm volatile("s_waitcnt lgkmcnt(0)" ::: "memory")
#define VM_WAIT() asm volatile("s_waitcnt vmcnt(0)" ::: "memory")
#define RLX_AGENT __ATOMIC_RELAXED, __HIP_MEMORY_SCOPE_AGENT

__device__ __forceinline__ unsigned f2bf(float f) { unsigned u = __builtin_bit_cast(unsigned, f); return (u + 0x7fffu + ((u >> 16) & 1u)) >> 16; }
__device__ __forceinline__ unsigned pk2(float lo, float hi) { return f2bf(lo) | (f2bf(hi) << 16); }
__device__ __forceinline__ unsigned cvt_pk_bf16(float lo, float hi) { unsigned r; asm volatile("v_cvt_pk_bf16_f32 %0, %1, %2" : "=v"(r) : "v"(lo), "v"(hi)); return r; }
__device__ __forceinline__ float bf_lo(unsigned w) { return __builtin_bit_cast(float, w << 16); }
__device__ __forceinline__ float bf_hi(unsigned w) { return __builtin_bit_cast(float, w & 0xffff0000u); }
__device__ __forceinline__ float bf1(bf16_t h) { return __builtin_bit_cast(float, (unsigned)h << 16); }
__device__ __forceinline__ unsigned pk_f16(float lo, float hi) { f16x2 v = {(_Float16)lo, (_Float16)hi}; return __builtin_bit_cast(unsigned, v); }
__device__ __forceinline__ float fast_exp(float x) { return __builtin_amdgcn_exp2f(x * LOG2E); }
__device__ __forceinline__ float fast_rcp(float x) { return __builtin_amdgcn_rcpf(x); }
__device__ __forceinline__ float silu_f(float v) { return v * fast_rcp(1.0f + fast_exp(-v)); }
__device__ __forceinline__ unsigned ld_agent(const unsigned* p) { return __hip_atomic_load((unsigned*)p, RLX_AGENT); }
typedef unsigned long long u64;
constexpr float SS_FIX = 1048576.0f;
__device__ __forceinline__ float rinv_of(u64 ssfix) { return __builtin_amdgcn_rsqf((float)ssfix * (1.0f / (SS_FIX * D)) + EPS); }

namespace pg8 {
constexpr int BM = 256, BK = 64, HALF = 128, HTB = HALF * BK * 2, STAGE_BYTES = 8 * HTB, NXCD = 8, WGM = 8;
__host__ __device__ __forceinline__ int lds_byte(int r, int c) { const int st = (r >> 4) * 2 + (c >> 5), rr = r & 15, cc = c & 31, ob = rr * 64 + cc * 2; return st * 1024 + (ob ^ (((ob >> 9) & 1) << 5)); }
__host__ __device__ __forceinline__ void stage_rc(int b, int& R, int& C) { const int st = b / 1024, sb = b % 1024, swz = sb ^ (((sb >> 9) & 1) << 5); R = (st >> 1) * 16 + swz / 64; C = (st & 1) * 32 + (swz % 64) / 2; }
__host__ __device__ __forceinline__ int perm32(int rho) { const int n = rho >> 4, i = rho & 15; return 8 * (i >> 2) + 4 * n + (i & 3); }

struct Unit { int pm, pn, e; };
struct Gemm { const bf16_t* A; const bf16_t* Bt; int K; size_t bstride  ; const int* rowtok  ; };

struct StaticOrder {
    int nM, nN, nwg, G, c; const int* tile_e;
    __device__ void init(int nM_, int nN_, int G_, int c_, const int* te = nullptr) { nM = nM_; nN = nN_; nwg = nM * nN; G = G_; c = c_; tile_e = te; }
    __device__ bool next(int i, Unit& u) const {
        const long L = (long)i * G + c; if (L >= nwg) return false;
        int wgid = (int)L; { const int q = nwg / NXCD, r = nwg % NXCD, xcd = wgid % NXCD, off = wgid / NXCD; wgid = (xcd < r ? xcd * (q + 1) : r * (q + 1) + (xcd - r) * q) + off; }
        const int nig = WGM * nN, gid = wgid / nig, fm = gid * WGM, gsz = (nM - fm) < WGM ? (nM - fm) : WGM;
        u.pm = fm + ((wgid % nig) % gsz); u.pn = (wgid % nig) / gsz;
        u.e = tile_e ? (int)__builtin_amdgcn_readfirstlane(ld_agent((const unsigned*)tile_e + u.pm)) : 0;
        return true;
    }
};

template <class Epi, class Sched, bool GATHER>
__device__ __forceinline__ void gemm_phase(LAS unsigned char* lds, const Gemm g, const Sched& S, const Epi& E) {
    const int tid = threadIdx.x, wid = __builtin_amdgcn_readfirstlane(tid >> 6), lane = tid & 63, wr = wid >> 2, wc = wid & 3, fr = lane & 15, fq = lane >> 4;
    const int K = g.K, nt = K / BK;
    unsigned voffA[2], voffB[2]; int RA[2], CA[2];
#pragma unroll
    for (int i = 0; i < 2; ++i) { int R, C; stage_rc(tid * 16 + i * 8192, R, C); const int Rb = (R & ~31) + perm32(R & 31);
        RA[i] = R; CA[i] = C; voffA[i] = (unsigned)(R * K + C) * 2u; voffB[i] = (unsigned)(Rb * K + C) * 2u; }
    const size_t kstep = (size_t)(BK * 2);
    const size_t hstep = (size_t)HALF * K * 2;
    const size_t tstep = 2 * hstep;
    const unsigned ldsw = (unsigned)wid * 1024u;
    const int aoff = lds_byte(wr * 64 + fr, fq * 8), boff = lds_byte(wc * 32 + fr, fq * 8);
#define PG8_SA(b, h) (((b) * 2 + (h)) * HTB)
#define PG8_SB(b, h) ((4 + (b) * 2 + (h)) * HTB)
#define PG8_STAGE(bufoff, gbase, voff) do { _Pragma("unroll") for (int _i = 0; _i < 2; ++_i) \
        __builtin_amdgcn_global_load_lds((const unsigned*)((const char*)(gbase) + (voff)[_i]), (LAS unsigned*)(lds + (bufoff) + ldsw + _i * 8192), 16, 0, 0); } while (0)
#define PG8_STAGE_B(b, h, q) do { const bool w_ = (q) >= nt; const char* gb_ = (w_ ? nB : cB) + (size_t)(h) * hstep + (size_t)(w_ ? (q) - nt : (q)) * kstep; PG8_STAGE(PG8_SB(b, h), gb_, voffB); } while (0)
#define PG8_STAGE_A(b, h, q) do { const bool w_ = (q) >= nt; \
        if constexpr (GATHER) { const char* gb_ = (const char*)g.A + (size_t)(w_ ? (q) - nt : (q)) * kstep; unsigned go_[2]; go_[0] = w_ ? goffn[h][0] : goff[h][0]; go_[1] = w_ ? goffn[h][1] : goff[h][1]; PG8_STAGE(PG8_SA(b, h), gb_, go_); } \
        else { const char* gb_ = (w_ ? nA : cA) + (size_t)(h) * hstep + (size_t)(w_ ? (q) - nt : (q)) * kstep; PG8_STAGE(PG8_SA(b, h), gb_, voffA); } } while (0)
#define PG8_LDA(dst, b, h) do { _Pragma("unroll") for (int m = 0; m < 4; ++m) _Pragma("unroll") for (int k = 0; k < 2; ++k) dst[m][k] = *(const LAS bf16x8*)(lds + PG8_SA(b, h) + aoff + m * 2048 + k * 1024); } while (0)
#define PG8_LDB(dst, b, h) do { _Pragma("unroll") for (int n = 0; n < 2; ++n) _Pragma("unroll") for (int k = 0; k < 2; ++k) dst[n][k] = *(const LAS bf16x8*)(lds + PG8_SB(b, h) + boff + n * 2048 + k * 1024); } while (0)
#define PG8_MMA(ai, bj, At, Bt) do { __builtin_amdgcn_s_setprio(1); _Pragma("unroll") for (int m = 0; m < 4; ++m) _Pragma("unroll") for (int n = 0; n < 2; ++n) _Pragma("unroll") for (int k = 0; k < 2; ++k) \
        acc[ai][bj][m][n] = __builtin_amdgcn_mfma_f32_16x16x32_bf16(Bt[n][k], At[m][k], acc[ai][bj][m][n], 0, 0, 0); __builtin_amdgcn_s_setprio(0); } while (0)
#define PG8_WAIT_V(n) asm volatile("s_waitcnt vmcnt(" #n ")" ::: "memory")
#define PG8_WAIT_L(n) asm volatile("s_waitcnt lgkmcnt(" #n ")" ::: "memory")
#define PG8_BAR __builtin_amdgcn_s_barrier()
#define PG8_SCHED __builtin_amdgcn_sched_barrier(0)
#define PG8_GOFF(dst, u) do { _Pragma("unroll") for (int h_ = 0; h_ < 2; ++h_) _Pragma("unroll") for (int i_ = 0; i_ < 2; ++i_) { \
        const int tk_ = g.rowtok[(u).pm * BM + h_ * HALF + RA[i_]]; dst[h_][i_] = (unsigned)((tk_ < 0 ? 0 : tk_) * K + CA[i_]) * 2u; } } while (0)
    Unit cur, nxt; int ui = 0;
    if (!S.next(0, cur)) return;
    f32x4 acc[2][2][4][2];
#pragma unroll
    for (int a = 0; a < 2; ++a)
#pragma unroll
        for (int b = 0; b < 2; ++b)
#pragma unroll
            for (int m = 0; m < 4; ++m)
#pragma unroll
                for (int n = 0; n < 2; ++n) acc[a][b][m][n] = (f32x4){0.f, 0.f, 0.f, 0.f};
    bf16x8 At[4][2], B0[2][2], B1[2][2];
    unsigned goff[2][2], goffn[2][2];
    if constexpr (GATHER) { PG8_GOFF(goff, cur); } else { goff[0][0] = goff[0][1] = goff[1][0] = goff[1][1] = 0u; }
#pragma unroll
    for (int h_ = 0; h_ < 2; ++h_) { goffn[h_][0] = goff[h_][0]; goffn[h_][1] = goff[h_][1]; }
    const char* cA = (const char*)g.A + (GATHER ? (size_t)0 : (size_t)cur.pm * tstep);
    const char* cB = (const char*)g.Bt + ((size_t)cur.e * g.bstride) * 2 + (size_t)cur.pn * tstep;
    const char* nA = cA; const char* nB = cB;
    PG8_STAGE_B(0, 0, 0); PG8_STAGE_B(0, 1, 0); PG8_STAGE_A(0, 0, 0); PG8_STAGE_A(0, 1, 0);
    if (wr == 1) PG8_BAR;
    PG8_WAIT_V(2); PG8_BAR;
    PG8_STAGE_B(1, 0, 1); PG8_STAGE_A(1, 0, 1); PG8_STAGE_B(1, 1, 1);
    PG8_WAIT_V(6); PG8_BAR;
    for (;;) {
        const bool has_next = S.next(ui + 1, nxt);
        if (!has_next) nxt = cur;
        nA = (const char*)g.A + (GATHER ? (size_t)0 : (size_t)nxt.pm * tstep);
        nB = (const char*)g.Bt + ((size_t)nxt.e * g.bstride) * 2 + (size_t)nxt.pn * tstep;
        if constexpr (GATHER) { if (has_next) { PG8_GOFF(goffn, nxt); } }
        for (int t = 0; t < nt; t += 2) {
            PG8_LDB(B0, 0, 0); PG8_LDB(B1, 0, 1); PG8_SCHED; PG8_LDA(At, 0, 0); PG8_STAGE_A(1, 1, t + 1);
            PG8_WAIT_V(8); PG8_WAIT_L(0); PG8_BAR; PG8_MMA(0, 0, At, B0); PG8_MMA(0, 1, At, B1); PG8_BAR; PG8_SCHED;
            PG8_LDA(At, 0, 1); PG8_STAGE_B(0, 0, t + 2); PG8_STAGE_B(0, 1, t + 2); PG8_STAGE_A(0, 0, t + 2);
            PG8_WAIT_V(8); PG8_WAIT_L(0); PG8_BAR; PG8_MMA(1, 0, At, B0); PG8_MMA(1, 1, At, B1); PG8_BAR; PG8_SCHED;
            PG8_LDB(B0, 1, 0); PG8_LDB(B1, 1, 1); PG8_SCHED; PG8_LDA(At, 1, 0); PG8_STAGE_A(0, 1, t + 2);
            PG8_WAIT_V(8); PG8_WAIT_L(0); PG8_BAR; PG8_MMA(0, 0, At, B0); PG8_MMA(0, 1, At, B1); PG8_BAR; PG8_SCHED;
            PG8_LDA(At, 1, 1); PG8_STAGE_B(1, 0, t + 3); PG8_STAGE_B(1, 1, t + 3); PG8_STAGE_A(1, 0, t + 3);
            PG8_WAIT_V(8); PG8_WAIT_L(0); PG8_BAR; PG8_MMA(1, 0, At, B0); PG8_MMA(1, 1, At, B1); PG8_BAR; PG8_SCHED;
        }
        if (wr == 0) PG8_BAR;
        E(acc, cur, wr, wc, fr, fq);
        if (!has_next) break;
#pragma unroll
        for (int a = 0; a < 2; ++a)
#pragma unroll
            for (int b = 0; b < 2; ++b)
#pragma unroll
                for (int m = 0; m < 4; ++m)
#pragma unroll
                    for (int n = 0; n < 2; ++n) acc[a][b][m][n] = (f32x4){0.f, 0.f, 0.f, 0.f};
        cur = nxt; cA = nA; cB = nB; ++ui;
#pragma unroll
        for (int h_ = 0; h_ < 2; ++h_) { goff[h_][0] = goffn[h_][0]; goff[h_][1] = goffn[h_][1]; }
        if (wr == 1) PG8_BAR;
    }
    PG8_WAIT_V(0);
    PG8_BAR;
#undef PG8_SA
#undef PG8_SB
#undef PG8_STAGE
#undef PG8_STAGE_A
#undef PG8_STAGE_B
#undef PG8_LDA
#undef PG8_LDB
#undef PG8_MMA
#undef PG8_WAIT_V
#undef PG8_WAIT_L
#undef PG8_BAR
#undef PG8_SCHED
#undef PG8_GOFF
}
}

#define XB_TMO      128
#define XB_XCNT(j)  (256  + 64 * (j))
#define XB_XSUB(j)  (1280 + 64 * (j))
#define XB_XGEN(j)  (2304 + 64 * (j))
#define XB_TOP      3328
#define XB_TOPGEN   3392
#define XCD_BAR_WORDS 3456
#define XB_SPIN_CAP (1u << 18)
__device__ __forceinline__ unsigned xb_ld(unsigned* p)              { return __hip_atomic_load(p, __ATOMIC_RELAXED, __HIP_MEMORY_SCOPE_AGENT); }
__device__ __forceinline__ unsigned xb_add(unsigned* p, unsigned v) { return __hip_atomic_fetch_add(p, v, __ATOMIC_RELAXED, __HIP_MEMORY_SCOPE_AGENT); }
__device__ __forceinline__ unsigned xb_xcc_id() { return (unsigned)__builtin_amdgcn_s_getreg((3 << 11) | 20) & 0xFu; }
#define XB_SPIN(cond, bar) do { unsigned _sp = 0; while (cond) { __builtin_amdgcn_s_sleep(1); \
    if ((++_sp & 255u) == 0u) { if (xb_ld(&(bar)[XB_TMO])) break; if (_sp > XB_SPIN_CAP) { atomicAdd(&(bar)[XB_TMO], 1u); break; } } } } while (0)
struct XcdBarrier { unsigned* bar; unsigned x; volatile LAS unsigned* st; };
__device__ __forceinline__ XcdBarrier xcd_barrier_post(unsigned* bar, volatile LAS unsigned* st) {
    XcdBarrier b; b.bar = bar; b.x = xb_xcc_id(); b.st = st;
    if (threadIdx.x == 0) (void)xb_add(&bar[XB_XCNT(b.x)], 1u);
    return b;
}
__device__ __forceinline__ void xcd_barrier_complete(unsigned* bar, unsigned x, unsigned& nloc, unsigned& nx) {
    const unsigned G = gridDim.x * gridDim.y * gridDim.z;
    unsigned sum, cnt, mine, sp = 0u;
    for (;;) {
        sum = 0u; cnt = 0u; mine = 0u;
#pragma unroll
        for (unsigned j = 0; j < 16; ++j) { const unsigned c = xb_ld(&bar[XB_XCNT(j)]); sum += c; cnt += (c > 0u) ? 1u : 0u; mine = (j == x) ? c : mine; }
        if (sum == G) break;
        __builtin_amdgcn_s_sleep(1);
        if ((++sp & 255u) == 0u) { if (xb_ld(&bar[XB_TMO])) break; if (sp > XB_SPIN_CAP) { atomicAdd(&bar[XB_TMO], 1u); break; } }
    }
    nloc = mine > 0u ? mine : 1u; nx = cnt > 0u ? cnt : 1u;
}
__device__ __forceinline__ void xcd_barrier(const XcdBarrier& b) {
    asm volatile("s_waitcnt vmcnt(0)" ::: "memory");
    __syncthreads();
    if (threadIdx.x == 0) {
        unsigned* bar = b.bar;
        __builtin_amdgcn_s_waitcnt(0);
        unsigned nloc = b.st[0], nx = b.st[1];
        if (nloc == 0u) { xcd_barrier_complete(bar, b.x, nloc, nx); b.st[0] = nloc; b.st[1] = nx; }
        const unsigned old = xb_add(&bar[XB_XSUB(b.x)], 1u);
        const unsigned gen = old / nloc;
        if (old + 1u == (gen + 1u) * nloc) {
            __builtin_amdgcn_fence(__ATOMIC_RELEASE, "agent");
            asm volatile("s_waitcnt vmcnt(0)" ::: "memory");
            const unsigned og = xb_add(&bar[XB_TOP], 1u);
            const unsigned tg = og / nx;
            if (og + 1u == (tg + 1u) * nx) xb_add(&bar[XB_TOPGEN], 1u);
            else XB_SPIN(xb_ld(&bar[XB_TOPGEN]) == tg, bar);
            __builtin_amdgcn_fence(__ATOMIC_ACQUIRE, "agent");
            xb_add(&bar[XB_XGEN(b.x)], 1u);
            asm volatile("s_waitcnt vmcnt(0)" ::: "memory");
        } else {
            XB_SPIN(xb_ld(&bar[XB_XGEN(b.x)]) == gen, bar);
            __builtin_amdgcn_fence(__ATOMIC_ACQUIRE, "agent");
            asm volatile("s_waitcnt vmcnt(0)" ::: "memory");
        }
    }
    __syncthreads();
}

struct Frame {
    LAS unsigned char* lds;
    int tid, lane, wave, vcu, G;
};
__device__ __forceinline__ float wave_sum(float v) {
#pragma unroll
    for (int o = 1; o < 64; o <<= 1) v += __shfl_xor(v, o);
    return v;
}
__device__ __forceinline__ void transpose_item(const float* W, int K, int N, int k0, int nsrc0, bf16_t* WT, int drow0, const float* gain, LAS float* scr, int lane) {
#pragma unroll 8
    for (int i = 0; i < 32; ++i) { const int kk = 2 * i + (lane >> 5); float v = W[(size_t)(k0 + kk) * N + nsrc0 + (lane & 31)]; if (gain) v *= gain[k0 + kk]; scr[kk * 33 + (lane & 31)] = v; }
    LDS_WAIT(); asm volatile("" ::: "memory");
    const int c = lane & 7;
#pragma unroll
    for (int j = 0; j < 4; ++j) { const int n = (lane >> 3) + 8 * j; const LAS float* s = scr + (8 * c) * 33 + n;
        u32x4 o; o.x = pk2(s[0 * 33], s[1 * 33]); o.y = pk2(s[2 * 33], s[3 * 33]); o.z = pk2(s[4 * 33], s[5 * 33]); o.w = pk2(s[6 * 33], s[7 * 33]);
        *(GAS u32x4*)(WT + (size_t)(drow0 + n) * K + k0 + 8 * c) = o; }
    LDS_WAIT(); asm volatile("" ::: "memory");
}
template <int MAP>
__device__ __forceinline__ void transpose_mat(const float* W, int K, int N, int ncol0, int ncols, bf16_t* WT, int roff, const float* gain, LAS float* scr, int lane, int it) {
    const int nblk = ncols / 32, kb = it / nblk, nb = it % nblk, n = 32 * nb;
    int drow;
    if (MAP == 0) drow = roff + n;
    else if (MAP == 1) drow = (n / 128) * 256 + roff + (n % 128);
    else { const int head = n / 64, d = n % 64; drow = roff + (head / 4) * 256 + (d / 32) * 128 + (head % 4) * 32; }
    transpose_item(W, K, N, 64 * kb, ncol0 + n, WT, drow, gain, scr, lane);
}

namespace epi {
using pg8::Unit;
#define EPI_ARGS const f32x4 (&acc)[2][2][4][2], const Unit& u, int wr, int wc, int fr, int fq
__device__ __forceinline__ u32x4 pack8(f32x4 v0, f32x4 v1) { u32x4 w; w.x = cvt_pk_bf16(v0[0], v0[1]); w.y = cvt_pk_bf16(v0[2], v0[3]); w.z = cvt_pk_bf16(v1[0], v1[1]); w.w = cvt_pk_bf16(v1[2], v1[3]); return w; }
__device__ __forceinline__ void unpack8(u32x4 w, f32x4& v0, f32x4& v1) { v0 = (f32x4){bf_lo(w.x), bf_hi(w.x), bf_lo(w.y), bf_hi(w.y)}; v1 = (f32x4){bf_lo(w.z), bf_hi(w.z), bf_lo(w.w), bf_hi(w.w)}; }
__device__ __forceinline__ f32x4 silu4(f32x4 v) { return (f32x4){silu_f(v[0]), silu_f(v[1]), silu_f(v[2]), silu_f(v[3])}; }
__device__ __forceinline__ float sumsq4(f32x4 v) { return (v[0] * v[0] + v[1] * v[1]) + (v[2] * v[2] + v[3] * v[3]); }

struct EpiQO {
    bf16_t* Q1; bf16_t* OG1;
    __device__ __forceinline__ void operator()(EPI_ARGS) const {
        const bool isq = u.pn < 4; bf16_t* base = isq ? Q1 : OG1; const int colt = (u.pn & 3) * 256 + wc * 32 + 8 * fq;
#pragma unroll
        for (int ai = 0; ai < 2; ++ai)
#pragma unroll
            for (int m = 0; m < 4; ++m) { bf16_t* rowp = base + (size_t)(u.pm * 256 + ai * 128 + wr * 64 + m * 16 + fr) * D + colt;
#pragma unroll
                for (int bj = 0; bj < 2; ++bj) { f32x4 v0 = acc[ai][bj][m][0], v1 = acc[ai][bj][m][1]; if (!isq) { v0 = silu4(v0); v1 = silu4(v1); }
                    *(u32x4*)(rowp + bj * 128) = pack8(v0, v1); } }
    }
};
struct EpiFI {
    unsigned short* GT; bf16_t* VT; const float* LB;
    __device__ __forceinline__ void operator()(EPI_ARGS) const {
        const bool isf = u.pm < 4; const int tcol = u.pn * 256 + wc * 32 + 8 * fq;
#pragma unroll
        for (int ai = 0; ai < 2; ++ai)
#pragma unroll
            for (int m = 0; m < 4; ++m) { const int ch = (u.pm & 3) * 256 + ai * 128 + wr * 64 + m * 16 + fr;
                if (isf) { const float lb = LB[ch], om = 1.0f - lb; unsigned short* rowp = GT + (size_t)ch * T + tcol;
#pragma unroll
                    for (int bj = 0; bj < 2; ++bj) { float g[8];
#pragma unroll
                        for (int i = 0; i < 8; ++i) { const float v = acc[ai][bj][m][i >> 2][i & 3]; const float sg = fast_rcp(1.0f + fast_exp(-v)); g[i] = __builtin_amdgcn_logf(lb + om * sg) * 0.6931471805599453f; }
                        u32x4 w; w.x = pk_f16(g[0], g[1]); w.y = pk_f16(g[2], g[3]); w.z = pk_f16(g[4], g[5]); w.w = pk_f16(g[6], g[7]);
                        *(u32x4*)(rowp + bj * 128) = w; } }
                else { bf16_t* rowp = VT + (size_t)ch * T + tcol;
#pragma unroll
                    for (int bj = 0; bj < 2; ++bj) *(u32x4*)(rowp + bj * 128) = pack8(acc[ai][bj][m][0], acc[ai][bj][m][1]); } }
    }
};
template <bool BASE32, bool OUT32> struct EpiRes {
    const void* base; bf16_t* out; float* out32; u64* rowss;
    __device__ __forceinline__ void operator()(EPI_ARGS) const {
        const int colt = u.pn * 256 + wc * 32 + 8 * fq;
#pragma unroll
        for (int ai = 0; ai < 2; ++ai)
#pragma unroll
            for (int m = 0; m < 4; ++m) { const int row = u.pm * 256 + ai * 128 + wr * 64 + m * 16 + fr; const size_t off = (size_t)row * D + colt; float ss = 0.f;
#pragma unroll
                for (int bj = 0; bj < 2; ++bj) { f32x4 b0, b1;
                    if (BASE32) { const float* bp = (const float*)base + off + bj * 128; b0 = *(const f32x4*)bp; b1 = *(const f32x4*)(bp + 4); }
                    else { const u32x4 w = *(const u32x4*)((const bf16_t*)base + off + bj * 128); unpack8(w, b0, b1); }
                    const f32x4 h0 = acc[ai][bj][m][0] + b0, h1 = acc[ai][bj][m][1] + b1; ss += sumsq4(h0) + sumsq4(h1);
                    *(u32x4*)(out + off + bj * 128) = pack8(h0, h1);
                    if (OUT32) { float* op = out32 + off + bj * 128; *(f32x4*)op = h0; *(f32x4*)(op + 4) = h1; } }
                ss += __shfl_xor(ss, 16); ss += __shfl_xor(ss, 32);
                if (fq == 0) __hip_atomic_fetch_add(rowss + row, (u64)(ss * SS_FIX), RLX_AGENT); }
    }
};
template <bool MOE> struct EpiGU {
    bf16_t* hid; int ldh; const void* rsrc;
    __device__ __forceinline__ void operator()(EPI_ARGS) const {
        const int colt = u.pn * 128 + wc * 32 + 8 * fq;
#pragma unroll
        for (int ai = 0; ai < 2; ++ai)
#pragma unroll
            for (int m = 0; m < 4; ++m) { const int row = u.pm * 256 + ai * 128 + wr * 64 + m * 16 + fr;
                const float r = MOE ? ((const float*)rsrc)[row] : rinv_of(((const u64*)rsrc)[row]);
                f32x4 o[2];
#pragma unroll
                for (int n = 0; n < 2; ++n) { const f32x4 g = acc[ai][0][m][n] * r, up = acc[ai][1][m][n] * r; o[n] = silu4(g) * up; }
                *(u32x4*)(hid + (size_t)row * ldh + colt) = pack8(o[0], o[1]); }
    }
};
struct EpiQK {
    bf16_t* Q2; bf16_t* K2; const u64* rowss; const float* qgain; const float* kgain;
    __device__ __forceinline__ void operator()(EPI_ARGS) const {
        const bool isq = u.pn < 4; const float* gn = isq ? qgain : kgain; const float osc = isq ? 0.125f * LOG2E : 1.0f;
        f32x4 gv[2][2];
#pragma unroll
        for (int bj = 0; bj < 2; ++bj)
#pragma unroll
            for (int n = 0; n < 2; ++n) gv[bj][n] = *(const f32x4*)(gn + 32 * bj + 8 * fq + 4 * n) * osc;
        bf16_t* base = isq ? Q2 + (size_t)(4 * u.pn + wc) * 64 + 8 * fq : K2 + (size_t)wc * 64 + 8 * fq; const int ld = isq ? D : 256;
#pragma unroll
        for (int ai = 0; ai < 2; ++ai)
#pragma unroll
            for (int m = 0; m < 4; ++m) { const int row = u.pm * 256 + ai * 128 + wr * 64 + m * 16 + fr;
                const float r = rinv_of(rowss[row]);
                f32x4 y[2][2]; float ss = 0.f;
#pragma unroll
                for (int bj = 0; bj < 2; ++bj)
#pragma unroll
                    for (int n = 0; n < 2; ++n) { y[bj][n] = acc[ai][bj][m][n] * r; ss += sumsq4(y[bj][n]); }
                ss += __shfl_xor(ss, 16); ss += __shfl_xor(ss, 32);
                const float s = __builtin_amdgcn_rsqf(ss * (1.0f / HD) + EPS);
#pragma unroll
                for (int bj = 0; bj < 2; ++bj) *(u32x4*)(base + (size_t)row * ld + 32 * bj) = pack8(y[bj][0] * s * gv[bj][0], y[bj][1] * s * gv[bj][1]); }
    }
};
struct EpiVT {
    bf16_t* VT2; const u64* rowss;
    __device__ __forceinline__ void operator()(EPI_ARGS) const {
        const int tcol = u.pn * 256 + wc * 32 + 8 * fq; f32x4 rv[2][2];
#pragma unroll
        for (int bj = 0; bj < 2; ++bj)
#pragma unroll
            for (int n = 0; n < 2; ++n) {
#pragma unroll
                for (int i = 0; i < 4; ++i) rv[bj][n][i] = rinv_of(rowss[tcol + bj * 128 + 4 * n + i]); }
#pragma unroll
        for (int ai = 0; ai < 2; ++ai)
#pragma unroll
            for (int m = 0; m < 4; ++m) { const int ch = ai * 128 + wr * 64 + m * 16 + fr; bf16_t* rowp = VT2 + (size_t)ch * T + tcol;
#pragma unroll
                for (int bj = 0; bj < 2; ++bj) *(u32x4*)(rowp + bj * 128) = pack8(acc[ai][bj][m][0] * rv[bj][0], acc[ai][bj][m][1] * rv[bj][1]); }
    }
};
struct EpiMoeDown {
    float* out; const int* rtok; const float* rg;
    __device__ __forceinline__ void operator()(EPI_ARGS) const {
        const int colt = u.pn * 256 + wc * 32 + 8 * fq;
#pragma unroll
        for (int ai = 0; ai < 2; ++ai)
#pragma unroll
            for (int m = 0; m < 4; ++m) { const int prow = u.pm * 256 + ai * 128 + wr * 64 + m * 16 + fr; const int tok = rtok[prow]; const float gt = rg[prow];
                if (tok >= 0) { float* rowp = out + (size_t)tok * D + colt;
#pragma unroll
                    for (int bj = 0; bj < 2; ++bj) { float* p = rowp + bj * 128; const f32x4 o0 = *(const f32x4*)p, o1 = *(const f32x4*)(p + 4);
                        *(f32x4*)p = o0 + acc[ai][bj][m][0] * gt; *(f32x4*)(p + 4) = o1 + acc[ai][bj][m][1] * gt; } } }
    }
};
#undef EPI_ARGS
}

struct Ptrs {
    const float *x, *w_in, *hlb, *gnorm, *w_out, *w_q, *q_gain, *sink, *w_o, *kv_norm, *kv_w, *k_gain, *rel_bias, *attn_norm, *ffn_norm, *ffn_wg, *ffn_wu, *ffn_wd, *router, *moe_wg, *moe_wu, *moe_wd;
    float* out; unsigned char* ws;
};
__device__ __forceinline__ void p0_prologue(Frame& F, const Ptrs& P) {
    LAS float* scr = (LAS float*)(F.lds + F.wave * 16384);
    unsigned char* ws = P.ws;
    const int gw = F.vcu * 8 + F.wave, NGW = F.G * 8, lane = F.lane;
    constexpr int I_QO = 16 * 64, I_FI = 16 * 64, I_OUT = 16 * 32, I_G = 16 * 88, I_DN = 44 * 32, I_Q = 16 * 32, I_KV = 16 * 16, I_O = 16 * 32;
    constexpr int I_MG = 16 * 112, I_MD = 56 * 32;
    constexpr int N_SMALL = I_QO + I_FI + I_OUT + 2 * I_G + I_DN + I_Q + I_KV + I_O;
    constexpr int N_MOE = NE * (2 * I_MG + I_MD);
    for (int it = gw; it < N_SMALL + N_MOE; it += NGW) {
        int r = it;
        if (r < I_QO) { const int nblk = 64, kb = r / nblk, nb = r % nblk, n = 32 * nb;
            transpose_item(P.w_in, D, 4 * D, 64 * kb, n < 1024 ? n : n + 2048, (bf16_t*)(ws + WS_WQO), n, nullptr, scr, lane); continue; } r -= I_QO;
        if (r < I_FI) { const int nblk = 64, kb = r / nblk, nb = r % nblk, n = 32 * nb;
            transpose_item(P.w_in, D, 4 * D, 64 * kb, 1024 + n, (bf16_t*)(ws + WS_WFI), n, nullptr, scr, lane); continue; } r -= I_FI;
        if (r < I_OUT) { transpose_mat<0>(P.w_out, D, D, 0, D, (bf16_t*)(ws + WS_WOUT), 0, nullptr, scr, lane, r); continue; } r -= I_OUT;
        if (r < I_G) { transpose_mat<1>(P.ffn_wg, D, FF0, 0, FF0, (bf16_t*)(ws + WS_WGU), 0, P.ffn_norm, scr, lane, r); continue; } r -= I_G;
        if (r < I_G) { transpose_mat<1>(P.ffn_wu, D, FF0, 0, FF0, (bf16_t*)(ws + WS_WGU), 128, P.ffn_norm, scr, lane, r); continue; } r -= I_G;
        if (r < I_DN) { transpose_mat<0>(P.ffn_wd, FF0, D, 0, D, (bf16_t*)(ws + WS_WDN), 0, nullptr, scr, lane, r); continue; } r -= I_DN;
        if (r < I_Q) { transpose_mat<2>(P.w_q, D, D, 0, D, (bf16_t*)(ws + WS_WQK), 0, P.attn_norm + D, scr, lane, r); continue; } r -= I_Q;
        if (r < I_KV) { const int nblk = 16, kb = r / nblk, nb = r % nblk, n = 32 * nb;
            if (n < 256) { const int head = n / 64, d = n % 64; transpose_item(P.kv_w, D, 512, 64 * kb, n, (bf16_t*)(ws + WS_WQK), 1024 + (d / 32) * 128 + head * 32, P.kv_norm, scr, lane); }
            else transpose_item(P.kv_w, D, 512, 64 * kb, n, (bf16_t*)(ws + WS_WV), n - 256, P.kv_norm, scr, lane);
            continue; } r -= I_KV;
        if (r < I_O) { transpose_mat<0>(P.w_o, D, D, 0, D, (bf16_t*)(ws + WS_WO), 0, nullptr, scr, lane, r); continue; } r -= I_O;
        const int e = r / (2 * I_MG + I_MD); r -= e * (2 * I_MG + I_MD);
        if (r < I_MG) { transpose_mat<1>(P.moe_wg + (size_t)e * D * FFE, D, FFE, 0, FFE, (bf16_t*)(ws + WS_MGU) + (size_t)e * 2 * FFE * D, 0, P.ffn_norm + D, scr, lane, r); continue; } r -= I_MG;
        if (r < I_MG) { transpose_mat<1>(P.moe_wu + (size_t)e * D * FFE, D, FFE, 0, FFE, (bf16_t*)(ws + WS_MGU) + (size_t)e * 2 * FFE * D, 128, P.ffn_norm + D, scr, lane, r); continue; } r -= I_MG;
        transpose_mat<0>(P.moe_wd + (size_t)e * FFE * D, FFE, D, 0, D, (bf16_t*)(ws + WS_MDN) + (size_t)e * D * FFE, 0, nullptr, scr, lane, r);
    }
    if (blockIdx.x == 0) { for (int c = F.tid; c < D; c += 512) { const float a = P.hlb[c], b = P.hlb[D + c], d = P.hlb[2 * D + c]; const float mx = fmaxf(a, fmaxf(b, d));
        const float ea = __expf(a - mx), eb = __expf(b - mx), ed = __expf(d - mx); ((float*)(ws + WS_LB))[c] = ea / (ea + eb + ed); } }
    bf16_t* XN = (bf16_t*)(ws + WS_XN);
    f32x4 gn[4];
#pragma unroll
    for (int j = 0; j < 4; ++j) gn[j] = ((const f32x4*)P.attn_norm)[lane + 64 * j];
    for (int m = gw; m < T; m += NGW) {
        const GAS f32x4* xr = (const GAS f32x4*)(P.x + (size_t)m * D) + lane;
        f32x4 v[4]; float s = 0.f;
#pragma unroll
        for (int j = 0; j < 4; ++j) { v[j] = xr[64 * j]; s += ((v[j][0] * v[j][0] + v[j][1] * v[j][1]) + (v[j][2] * v[j][2] + v[j][3] * v[j][3])); }
        const float r = __builtin_amdgcn_rsqf(wave_sum(s) * (1.f / D) + EPS);
        GAS u32x2* o8 = (GAS u32x2*)(XN + (size_t)m * D) + lane;
#pragma unroll
        for (int j = 0; j < 4; ++j) { const f32x4 y = v[j] * r * gn[j]; u32x2 w; w.x = cvt_pk_bf16(y[0], y[1]); w.y = cvt_pk_bf16(y[2], y[3]); o8[64 * j] = w; }
    }
}

__device__ __forceinline__ void scan_phase_a(Frame& F, bf16_t* Q1, unsigned short* GT, const bf16_t* VT, float* DCH, bf16_t* OINTRA) {
    constexpr int QP = 272, VP = 144, L_QE = 0, L_KE = 64 * QP, L_VT = 2 * 64 * QP, L_SEG = L_VT + 128 * VP;
    LAS unsigned char* lds = F.lds;
    const int tid = F.tid, lane = F.lane, w = F.wave, ch = tid & 127, seg = tid >> 7, l31 = lane & 31, hh = lane >> 5;
    for (int chunk = F.vcu; chunk < BATCH * HG_H * NCHK; chunk += F.G) {
        const int b = chunk >> 10, h = (chunk >> 7) & 7, c = chunk & 127;
        const size_t row0 = (size_t)b * SEQ + (size_t)c * CHK; const int col0 = h * HG_DK;
        unsigned short* gp = GT + (size_t)(col0 + ch) * T + row0 + 16 * seg;
        const u32x4 g0 = *(const u32x4*)gp, g1 = *(const u32x4*)(gp + 8);
        float qv[16];
#pragma unroll
        for (int i = 0; i < 16; ++i) qv[i] = bf1(Q1[(row0 + 16 * seg + i) * D + col0 + ch]);
        { const int e = tid >> 2, part = tid & 3; const bf16_t* vp = VT + (size_t)(col0 + e) * T + row0 + 16 * part;
          const u32x4 v0 = *(const u32x4*)vp, v1 = *(const u32x4*)(vp + 8);
          *(LAS u32x4*)(lds + L_VT + e * VP + part * 32) = v0; *(LAS u32x4*)(lds + L_VT + e * VP + part * 32 + 16) = v1; }
        float gl[16];
        { const unsigned gw_[8] = {g0.x, g0.y, g0.z, g0.w, g1.x, g1.y, g1.z, g1.w};
#pragma unroll
          for (int i = 0; i < 8; ++i) { const f16x2 p = __builtin_bit_cast(f16x2, gw_[i]); gl[2 * i] = (float)p[0]; gl[2 * i + 1] = (float)p[1]; } }
        float cs[16]; { float a = 0.f;
#pragma unroll
          for (int i = 0; i < 16; ++i) { a += gl[i]; cs[i] = a; } }
        ((LAS float*)(lds + L_SEG))[seg * 128 + ch] = cs[15];
        LDS_WAIT(); __syncthreads();
        float off = 0.f, blast = 0.f;
#pragma unroll
        for (int s = 0; s < 4; ++s) { const float tsum = ((LAS float*)(lds + L_SEG))[s * 128 + ch]; if (s < seg) off += tsum; blast += tsum; }
        unsigned kdw[8];
#pragma unroll
        for (int i = 0; i < 16; i += 2) { float kd2[2];
#pragma unroll
            for (int j = 0; j < 2; ++j) { const int ii = i + j; const float bt = off + cs[ii]; const float kk = 1.0f - fast_exp(gl[ii]);
                const float qe = qv[ii] * fast_exp(bt), ke = kk * fast_exp(-fmaxf(bt, -80.f)); kd2[j] = kk * fast_exp(blast - bt);
                const int t = 16 * seg + ii; const bf16_t qb = (bf16_t)f2bf(qe);
                *(LAS bf16_t*)(lds + L_QE + t * QP + ch * 2) = qb; *(LAS bf16_t*)(lds + L_KE + t * QP + ch * 2) = (bf16_t)f2bf(ke);
                Q1[(row0 + t) * D + col0 + ch] = qb; }
            kdw[i >> 1] = pk2(kd2[0], kd2[1]); }
        *(u32x4*)gp = (u32x4){kdw[0], kdw[1], kdw[2], kdw[3]}; *(u32x4*)(gp + 8) = (u32x4){kdw[4], kdw[5], kdw[6], kdw[7]};
        if (seg == 0) DCH[(size_t)chunk * 128 + ch] = fast_exp(blast);
        LDS_WAIT(); __syncthreads();
        { const int tt = w & 1, et = w >> 1; f32x16 oacc = {};
          for (int st = 0; st <= tt; ++st) { f32x16 sacc = {};
#pragma unroll
              for (int kk = 0; kk < 8; ++kk) { const bf16x8 a = *(const LAS bf16x8*)(lds + L_KE + (32 * st + l31) * QP + (16 * kk + 8 * hh) * 2);
                  const bf16x8 bq = *(const LAS bf16x8*)(lds + L_QE + (32 * tt + l31) * QP + (16 * kk + 8 * hh) * 2);
                  sacc = __builtin_amdgcn_mfma_f32_32x32x16_bf16(a, bq, sacc, 0, 0, 0); }
              if (st == tt) {
#pragma unroll
                  for (int r = 0; r < 16; ++r) { const int sl = (r & 3) + 8 * (r >> 2) + 4 * hh; if (sl > l31) sacc[r] = 0.f; } }
#pragma unroll
              for (int s2 = 0; s2 < 2; ++s2) { u32x4 pw; pw.x = cvt_pk_bf16(sacc[8 * s2 + 0], sacc[8 * s2 + 1]); pw.y = cvt_pk_bf16(sacc[8 * s2 + 2], sacc[8 * s2 + 3]);
                  pw.z = cvt_pk_bf16(sacc[8 * s2 + 4], sacc[8 * s2 + 5]); pw.w = cvt_pk_bf16(sacc[8 * s2 + 6], sacc[8 * s2 + 7]);
                  const LAS unsigned char* vb = lds + L_VT + (32 * et + l31) * VP + (32 * st + 16 * s2 + 4 * hh) * 2;
                  const u32x2 lo = *(const LAS u32x2*)vb, hi = *(const LAS u32x2*)(vb + 16);
                  const u32x4 vw = {lo.x, lo.y, hi.x, hi.y};
                  oacc = __builtin_amdgcn_mfma_f32_32x32x16_bf16(__builtin_bit_cast(bf16x8, pw), __builtin_bit_cast(bf16x8, vw), oacc, 0, 0, 0); } }
#pragma unroll
          for (int r = 0; r < 16; ++r) { const int t = 32 * tt + (r & 3) + 8 * (r >> 2) + 4 * hh; OINTRA[(row0 + t) * D + col0 + 32 * et + l31] = (bf16_t)f2bf(oacc[r]); } }
        LDS_WAIT(); __syncthreads();
    }
}
__device__ __forceinline__ void scan_phase_b(Frame& F, const bf16_t* QE, const bf16_t* KDT, const bf16_t* VT, const float* DCH, const bf16_t* OINTRA, const bf16_t* OG1, const float* gnorm, bf16_t* OGATED) {
    if (F.vcu >= BATCH * HG_H) return;
    constexpr int QP = 272, KP = 144, SL_K = 64 * QP, SL_D = SL_K + 128 * KP, SLOT = SL_D + 512, L_RED = 3 * SLOT;
    LAS unsigned char* lds = F.lds;
    const int tid = F.tid, lane = F.lane, w = F.wave, l15 = lane & 15, g = lane >> 4;
    const int b = F.vcu >> 3, h = F.vcu & 7; const int col0 = h * HG_DK; const size_t rowb = (size_t)b * SEQ;
    const int chunk0 = F.vcu * NCHK;
    const int qrow[2] = {tid >> 4, (tid + 512) >> 4}, qc = tid & 15, krow[2] = {tid >> 3, (tid + 512) >> 3}, kc = tid & 7;
    u32x4 sq[2], sk[2]; float sd = 0.f;
#define SB_LOAD(cc) do { const size_t r0_ = rowb + (size_t)(cc) * CHK; \
        _Pragma("unroll") for (int i_ = 0; i_ < 2; ++i_) { sq[i_] = *(const u32x4*)(QE + (r0_ + qrow[i_]) * D + col0 + qc * 8); sk[i_] = *(const u32x4*)(KDT + (size_t)(col0 + krow[i_]) * T + r0_ + kc * 8); } \
        if (tid < 128) sd = DCH[(size_t)(chunk0 + (cc)) * 128 + tid]; } while (0)
#define SB_WRITE(slot) do { LAS unsigned char* s_ = lds + (slot) * SLOT; \
        _Pragma("unroll") for (int i_ = 0; i_ < 2; ++i_) { *(LAS u32x4*)(s_ + qrow[i_] * QP + qc * 16) = sq[i_]; *(LAS u32x4*)(s_ + SL_K + krow[i_] * KP + kc * 16) = sk[i_]; } \
        if (tid < 128) *(LAS float*)(s_ + SL_D + tid * 4) = sd; } while (0)
    u32x4 pv[2]; u32x2 poi[4], pog[4];
#define SB_LOADW(cc) do { const size_t r0_ = rowb + (size_t)(cc) * CHK; \
        _Pragma("unroll") for (int s_ = 0; s_ < 2; ++s_) pv[s_] = *(const u32x4*)(VT + (size_t)(col0 + 16 * w + l15) * T + r0_ + 32 * s_ + 8 * g); \
        _Pragma("unroll") for (int t_ = 0; t_ < 4; ++t_) { const size_t o_ = (r0_ + 16 * t_ + l15) * D + col0 + 16 * w + 4 * g; poi[t_] = *(const u32x2*)(OINTRA + o_); pog[t_] = *(const u32x2*)(OG1 + o_); } } while (0)
    f32x4 S[8];
#pragma unroll
    for (int k = 0; k < 8; ++k) S[k] = (f32x4){0.f, 0.f, 0.f, 0.f};
    const f32x4 gnv = *(const f32x4*)(gnorm + 16 * w + 4 * g);
    SB_LOAD(0); SB_WRITE(0); SB_LOAD(1); SB_WRITE(1);
    LDS_WAIT(); __syncthreads();
    SB_LOADW(0);
    int slot = 0;
    for (int c = 0; c < NCHK; ++c) {
        const LAS unsigned char* sl = lds + slot * SLOT;
        if (c + 2 < NCHK) SB_LOAD(c + 2);
        const u32x4 cv0 = pv[0], cv1 = pv[1]; u32x2 coi[4], cog[4];
#pragma unroll
        for (int t_ = 0; t_ < 4; ++t_) { coi[t_] = poi[t_]; cog[t_] = pog[t_]; }
        if (c + 1 < NCHK) SB_LOADW(c + 1);
        f32x4 o[4];
#pragma unroll
        for (int t_ = 0; t_ < 4; ++t_) o[t_] = (f32x4){0.f, 0.f, 0.f, 0.f};
#pragma unroll
        for (int sp = 0; sp < 4; ++sp) { u32x4 aw; aw.x = cvt_pk_bf16(S[2 * sp][0], S[2 * sp][1]); aw.y = cvt_pk_bf16(S[2 * sp][2], S[2 * sp][3]); aw.z = cvt_pk_bf16(S[2 * sp + 1][0], S[2 * sp + 1][1]); aw.w = cvt_pk_bf16(S[2 * sp + 1][2], S[2 * sp + 1][3]);
#pragma unroll
            for (int t_ = 0; t_ < 4; ++t_) { const LAS unsigned char* qb = sl + (16 * t_ + l15) * QP + (32 * sp + 4 * g) * 2; const u32x2 lo = *(const LAS u32x2*)qb, hi = *(const LAS u32x2*)(qb + 32);
                const u32x4 bw = {lo.x, lo.y, hi.x, hi.y};
                o[t_] = __builtin_amdgcn_mfma_f32_16x16x32_bf16(__builtin_bit_cast(bf16x8, aw), __builtin_bit_cast(bf16x8, bw), o[t_], 0, 0, 0); } }
        LAS float* red = (LAS float*)(lds + L_RED) + (c & 1) * 512;
#pragma unroll
        for (int t_ = 0; t_ < 4; ++t_) { o[t_] += (f32x4){bf_lo(coi[t_].x), bf_hi(coi[t_].x), bf_lo(coi[t_].y), bf_hi(coi[t_].y)};
            float ss = (o[t_][0] * o[t_][0] + o[t_][1] * o[t_][1]) + (o[t_][2] * o[t_][2] + o[t_][3] * o[t_][3]); ss += __shfl_xor(ss, 16); ss += __shfl_xor(ss, 32);
            if (g == 0) red[w * 64 + 16 * t_ + l15] = ss; }
#pragma unroll
        for (int kt = 0; kt < 8; ++kt) { const f32x4 dv = *(const LAS f32x4*)(sl + SL_D + (16 * kt + 4 * g) * 4); f32x4 cacc = S[kt] * dv;
            const bf16x8 a0 = *(const LAS bf16x8*)(sl + SL_K + (16 * kt + l15) * KP + (8 * g) * 2), a1 = *(const LAS bf16x8*)(sl + SL_K + (16 * kt + l15) * KP + (32 + 8 * g) * 2);
            cacc = __builtin_amdgcn_mfma_f32_16x16x32_bf16(a0, __builtin_bit_cast(bf16x8, cv0), cacc, 0, 0, 0);
            cacc = __builtin_amdgcn_mfma_f32_16x16x32_bf16(a1, __builtin_bit_cast(bf16x8, cv1), cacc, 0, 0, 0); S[kt] = cacc; }
        const int wslot = slot == 0 ? 2 : slot - 1;
        if (c + 2 < NCHK) SB_WRITE(wslot);
        LDS_WAIT(); __syncthreads();
        const size_t r0 = rowb + (size_t)c * CHK;
#pragma unroll
        for (int t_ = 0; t_ < 4; ++t_) { float tot = 0.f;
#pragma unroll
            for (int ww = 0; ww < 8; ++ww) tot += red[ww * 64 + 16 * t_ + l15];
            const float rinv = __builtin_amdgcn_rsqf(tot * (1.0f / HG_DK) + EPS);
            const f32x4 og = {bf_lo(cog[t_].x), bf_hi(cog[t_].x), bf_lo(cog[t_].y), bf_hi(cog[t_].y)};
            const f32x4 y = o[t_] * rinv * gnv * og; u32x2 wv; wv.x = cvt_pk_bf16(y[0], y[1]); wv.y = cvt_pk_bf16(y[2], y[3]);
            *(u32x2*)(OGATED + (r0 + 16 * t_ + l15) * D + col0 + 16 * w + 4 * g) = wv; }
        slot = slot == 2 ? 0 : slot + 1;
    }
#undef SB_LOAD
#undef SB_WRITE
#undef SB_LOADW
}

__device__ __forceinline__ void attn_phase(Frame& F, const bf16_t* Q2, const bf16_t* K2, const bf16_t* VT2, const float* rel_bias, const float* sink, bf16_t* AO) {
    LAS float* BT = (LAS float*)F.lds;
    for (int idx = F.tid; idx < QH * WIN; idx += 512) { const int hq = idx >> 7, n = idx & 127; int bk;
        if (n < 16) bk = n; else { bk = 16 + (int)(__logf((float)n * (1.0f / 16.0f)) / __logf(8.0f) * 16.0f); bk = bk > 31 ? 31 : bk; }
        BT[idx] = rel_bias[bk * QH + hq] * LOG2E; }
    LDS_WAIT(); __syncthreads();
    const int lane = F.lane, w = F.wave, l31 = lane & 31, hh = lane >> 5;
    constexpr int NITEM = BATCH * KVH * (SEQ / 64);
    for (int it = F.vcu; it < NITEM; it += F.G) {
        const int b = it / (KVH * (SEQ / 64)), kvh = (it / (SEQ / 64)) % KVH, pg = it % (SEQ / 64);
        const int hq = 4 * kvh + (w & 3), p0 = 64 * pg + 32 * (w >> 2);
        const size_t rowb = (size_t)b * SEQ;
        bf16x8 qf[4];
#pragma unroll
        for (int kk = 0; kk < 4; ++kk) qf[kk] = *(const bf16x8*)(Q2 + (rowb + p0 + l31) * D + hq * HD + 16 * kk + 8 * hh);
        f32x16 s[5];
        const int j0 = p0 >= 128 ? 0 : (128 - p0) / 32;
#pragma unroll
        for (int j = 0; j < 5; ++j) { s[j] = (f32x16){};
            if (j >= j0) { const int kb = p0 - 128 + 32 * j;
#pragma unroll
                for (int kk = 0; kk < 4; ++kk) { const bf16x8 kf = *(const bf16x8*)(K2 + (rowb + kb + l31) * 256 + kvh * HD + 16 * kk + 8 * hh);
                    s[j] = __builtin_amdgcn_mfma_f32_32x32x16_bf16(kf, qf[kk], s[j], 0, 0, 0); } } }
        const float zs = sink[hq] * LOG2E; float mx = zs;
        const LAS float* bth = BT + hq * WIN;
#pragma unroll
        for (int j = 0; j < 5; ++j)
#pragma unroll
            for (int r = 0; r < 16; ++r) { const int kl = (r & 3) + 8 * (r >> 2) + 4 * hh; const int dist = l31 + 128 - 32 * j - kl;
                const bool ok = (j >= j0) && dist >= 0 && dist < WIN; const float z = ok ? s[j][r] + bth[dist & 127] : -INFINITY; s[j][r] = z; mx = fmaxf(mx, z); }
        mx = fmaxf(mx, __shfl_xor(mx, 32));
        float den = 0.f;
#pragma unroll
        for (int j = 0; j < 5; ++j)
#pragma unroll
            for (int r = 0; r < 16; ++r) { const float p = __builtin_amdgcn_exp2f(s[j][r] - mx); s[j][r] = p; den += p; }
        den += __shfl_xor(den, 32); den += __builtin_amdgcn_exp2f(zs - mx);
        const float inv = fast_rcp(den);
        f32x16 o[2]; o[0] = (f32x16){}; o[1] = (f32x16){};
#pragma unroll
        for (int j = 0; j < 5; ++j) { if (j >= j0) { const int kb = p0 - 128 + 32 * j;
#pragma unroll
            for (int s2 = 0; s2 < 2; ++s2) { u32x4 pw; pw.x = cvt_pk_bf16(s[j][8 * s2 + 0], s[j][8 * s2 + 1]); pw.y = cvt_pk_bf16(s[j][8 * s2 + 2], s[j][8 * s2 + 3]);
                pw.z = cvt_pk_bf16(s[j][8 * s2 + 4], s[j][8 * s2 + 5]); pw.w = cvt_pk_bf16(s[j][8 * s2 + 6], s[j][8 * s2 + 7]);
#pragma unroll
                for (int dt = 0; dt < 2; ++dt) { const bf16_t* vp = VT2 + (size_t)(kvh * HD + 32 * dt + l31) * T + rowb + kb + 16 * s2 + 4 * hh;
                    const u32x2 lo = *(const u32x2*)vp, hi = *(const u32x2*)(vp + 8); const u32x4 vw = {lo.x, lo.y, hi.x, hi.y};
                    o[dt] = __builtin_amdgcn_mfma_f32_32x32x16_bf16(__builtin_bit_cast(bf16x8, vw), __builtin_bit_cast(bf16x8, pw), o[dt], 0, 0, 0); } } } }
        bf16_t* orow = AO + (rowb + p0 + l31) * D + hq * HD;
#pragma unroll
        for (int dt = 0; dt < 2; ++dt)
#pragma unroll
            for (int i = 0; i < 4; ++i) { u32x2 wv; wv.x = cvt_pk_bf16(o[dt][4 * i] * inv, o[dt][4 * i + 1] * inv); wv.y = cvt_pk_bf16(o[dt][4 * i + 2] * inv, o[dt][4 * i + 3] * inv);
                *(u32x2*)(orow + 32 * dt + 8 * i + 4 * hh) = wv; }
    }
    __syncthreads();
}

__device__ __forceinline__ void router_phase(Frame& F, const float* H3, const float* router, const float* gain, gu32* ctl, int* LTOK, float* LG) {
    LAS float* WRG = (LAS float*)F.lds;
    LAS int* SEL = (LAS int*)(F.lds + 32768);
    LAS float* GATE = (LAS float*)(F.lds + 32768 + 1024);
    LAS int* RANK = (LAS int*)(F.lds + 32768 + 3072);
    LAS unsigned* CNT = (LAS unsigned*)(F.lds + 32768 + 5120);
    const int tid = F.tid, lane = F.lane, w = F.wave;
    for (int i = tid; i < D * NE; i += 512) WRG[i] = router[i] * gain[i >> 3];
    for (int tb = F.vcu; tb < T / 256; tb += F.G) {
        if (tid < 32) CNT[tid] = 0u;
        LDS_WAIT(); __syncthreads();
        for (int q = 0; q < 32; ++q) { const int tl = w * 32 + q; const size_t tok = (size_t)tb * 256 + tl;
            const GAS f32x4* xr = (const GAS f32x4*)(H3 + tok * D) + lane; float acc[8] = {0.f, 0.f, 0.f, 0.f, 0.f, 0.f, 0.f, 0.f}; float ss = 0.f;
#pragma unroll
            for (int j = 0; j < 4; ++j) { const f32x4 v = xr[64 * j];
#pragma unroll
                for (int i = 0; i < 4; ++i) { const LAS f32x4* wp = (const LAS f32x4*)(WRG + (4 * lane + 256 * j + i) * 8); const f32x4 w0 = wp[0], w1 = wp[1]; const float xv = v[i]; ss += xv * xv;
                    acc[0] += xv * w0[0]; acc[1] += xv * w0[1]; acc[2] += xv * w0[2]; acc[3] += xv * w0[3]; acc[4] += xv * w1[0]; acc[5] += xv * w1[1]; acc[6] += xv * w1[2]; acc[7] += xv * w1[3]; } }
            ss = wave_sum(ss);
#pragma unroll
            for (int e = 0; e < 8; ++e) acc[e] = wave_sum(acc[e]);
            const float r = __builtin_amdgcn_rsqf(ss * (1.0f / D) + EPS);
            int e1 = 0; float l1 = acc[0];
#pragma unroll
            for (int e = 1; e < 8; ++e) if (acc[e] > l1) { l1 = acc[e]; e1 = e; }
            int e2 = -1; float l2 = -INFINITY;
#pragma unroll
            for (int e = 0; e < 8; ++e) if (e != e1 && acc[e] > l2) { l2 = acc[e]; e2 = e; }
            const float g2 = 1.0f / (1.0f + __expf((l1 - l2) * r)), g1 = 1.0f - g2;
            if (lane == 0) { SEL[tl] = e1 | (e2 << 8); GATE[2 * tl] = g1; GATE[2 * tl + 1] = g2; } }
        LDS_WAIT(); __syncthreads();
        int e1 = 0, e2 = 0;
        if (tid < 256) { const int sv = SEL[tid]; e1 = sv & 255; e2 = sv >> 8; RANK[2 * tid] = (int)__hip_atomic_fetch_add(&CNT[e1], 1u, __ATOMIC_RELAXED, __HIP_MEMORY_SCOPE_WORKGROUP); RANK[2 * tid + 1] = (int)__hip_atomic_fetch_add(&CNT[8 + e2], 1u, __ATOMIC_RELAXED, __HIP_MEMORY_SCOPE_WORKGROUP); }
        LDS_WAIT(); __syncthreads();
        if (tid < 16) CNT[16 + tid] = __hip_atomic_fetch_add(ctl + CW_MCNT + 64 * tid, CNT[tid], RLX_AGENT);
        LDS_WAIT(); __syncthreads();
        if (tid < 256) { const int tok = tb * 256 + tid; const unsigned p1 = CNT[16 + e1] + (unsigned)RANK[2 * tid], p2 = CNT[24 + e2] + (unsigned)RANK[2 * tid + 1];
            LTOK[(size_t)e1 * T + p1] = tok; LG[(size_t)e1 * T + p1] = GATE[2 * tid];
            LTOK[(size_t)(8 + e2) * T + p2] = tok; LG[(size_t)(8 + e2) * T + p2] = GATE[2 * tid + 1]; }
        __syncthreads();
    }
}
__device__ __forceinline__ void moe_tiles(const gu32* ctl, int k, int* tstart  ) {
    int a = 0;
#pragma unroll
    for (int e = 0; e < NE; ++e) { tstart[e] = a; const unsigned c = __builtin_amdgcn_readfirstlane(ld_agent((const unsigned*)ctl + CW_MCNT + 64 * (k * 8 + e))); a += (int)((c + 255u) >> 8); }
    tstart[NE] = a;
}
__device__ __forceinline__ void rowtable_phase(Frame& F, const gu32* ctl, const int* LTOK, const float* LG, const u64* rowss, int* RTOK, float* RG, float* RRINV, int* TILEE) {
    for (int k = 0; k < 2; ++k) { int ts[9]; moe_tiles(ctl, k, ts);
        unsigned cnt[8];
#pragma unroll
        for (int e = 0; e < NE; ++e) cnt[e] = __builtin_amdgcn_readfirstlane(ld_agent((const unsigned*)ctl + CW_MCNT + 64 * (k * 8 + e)));
        const int nrows = ts[NE] * 256;
        for (int pr = F.vcu * 512 + F.tid; pr < nrows; pr += F.G * 512) { const int rt = pr >> 8; int e = 0; int st = 0; unsigned ce = cnt[0];
#pragma unroll
            for (int ee = 1; ee < NE; ++ee) if (rt >= ts[ee]) { e = ee; st = ts[ee]; ce = cnt[ee]; }
            const unsigned pos = (unsigned)(pr - st * 256); int tok = -1; float gt = 0.f, ri = 0.f;
            if (pos < ce) { tok = LTOK[(size_t)(k * 8 + e) * T + pos]; gt = LG[(size_t)(k * 8 + e) * T + pos]; ri = rinv_of(rowss[tok]); }
            RTOK[k * MPAD + pr] = tok; RG[k * MPAD + pr] = gt; RRINV[k * MPAD + pr] = ri;
            if ((pr & 255) == 0) TILEE[k * 512 + rt] = e; } }
}

struct Args { Ptrs p; int ph_lo, ph_hi; };
#ifndef DBG_STAGE
#define DBG_STAGE 99
#endif
__global__ void __launch_bounds__(512, 2) fwd_kernel(Args args) {
    extern __shared__ __attribute__((aligned(16))) unsigned char lds_raw[];
    Frame F;
    F.lds = (LAS unsigned char*)lds_raw;
    F.tid = threadIdx.x; F.lane = F.tid & 63; F.wave = __builtin_amdgcn_readfirstlane(F.tid >> 6);
    F.G = gridDim.x; { const int bx = blockIdx.x; F.vcu = (F.G % 8 == 0) ? (bx % 8) * (F.G / 8) + bx / 8 : bx; }
    const Ptrs& P = args.p;
    unsigned char* ws = P.ws;
    gu32* ctl = (gu32*)(ws + WS_CTL);
    volatile LAS unsigned* MISC = (volatile LAS unsigned*)(F.lds + MISC_OFF);
    for (int u = F.tid; u < (LDS_BYTES - RING_BYTES) / 4; u += 512) ((LAS unsigned*)(F.lds + RING_BYTES))[u] = 0u;
    __syncthreads();
    XcdBarrier bar = xcd_barrier_post((unsigned*)(ctl + CW_BAR), MISC + 8);
    const int lo = args.ph_lo, hi = args.ph_hi;
#define IN(k) (lo <= (k) && (k) < hi)
#define SEAM(k) do { if (IN(k) && IN((k) + 1)) xcd_barrier(bar); } while (0)
    using namespace pg8;
    const int bid = (int)blockIdx.x;
    u64* rowss1 = (u64*)(ws + WS_ROWSS1); u64* rowss2 = (u64*)(ws + WS_ROWSS2); u64* rowss3 = (u64*)(ws + WS_ROWSS3);

    if (IN(0)) { p0_prologue(F, P); } SEAM(0);
    if (IN(1)) { Gemm g{(const bf16_t*)(ws + WS_XN), (const bf16_t*)(ws + WS_WQO), D, 0, nullptr}; StaticOrder S; S.init(T / 256, 8, F.G, bid);
        epi::EpiQO E{(bf16_t*)(ws + WS_Q1), (bf16_t*)(ws + WS_OG1)}; gemm_phase<epi::EpiQO, StaticOrder, false>(F.lds, g, S, E); }
    if (IN(2)) { Gemm g{(const bf16_t*)(ws + WS_WFI), (const bf16_t*)(ws + WS_XN), D, 0, nullptr}; StaticOrder S; S.init(8, T / 256, F.G, bid);
        epi::EpiFI E{(unsigned short*)(ws + WS_GT), (bf16_t*)(ws + WS_VT), (const float*)(ws + WS_LB)}; gemm_phase<epi::EpiFI, StaticOrder, false>(F.lds, g, S, E); }
    SEAM(2);
    if (IN(3)) scan_phase_a(F, (bf16_t*)(ws + WS_Q1), (unsigned short*)(ws + WS_GT), (const bf16_t*)(ws + WS_VT), (float*)(ws + WS_DCH), (bf16_t*)(ws + WS_OINTRA));
    SEAM(3);
    if (IN(4)) scan_phase_b(F, (const bf16_t*)(ws + WS_Q1), (const bf16_t*)(ws + WS_GT), (const bf16_t*)(ws + WS_VT), (const float*)(ws + WS_DCH), (const bf16_t*)(ws + WS_OINTRA), (const bf16_t*)(ws + WS_OG1), P.gnorm, (bf16_t*)(ws + WS_OGATED));
    SEAM(4);
    if (IN(5)) { Gemm g{(const bf16_t*)(ws + WS_OGATED), (const bf16_t*)(ws + WS_WOUT), D, 0, nullptr}; StaticOrder S; S.init(T / 256, 4, F.G, bid);
        epi::EpiRes<true, DBG_STAGE == 1> E{P.x, (bf16_t*)(ws + WS_H1), P.out, rowss1}; gemm_phase<epi::EpiRes<true, DBG_STAGE == 1>, StaticOrder, false>(F.lds, g, S, E); }
    SEAM(5);
#if DBG_STAGE >= 2
    if (IN(6)) { Gemm g{(const bf16_t*)(ws + WS_H1), (const bf16_t*)(ws + WS_WGU), D, 0, nullptr}; StaticOrder S; S.init(T / 256, 2 * FF0 / 256, F.G, bid);
        epi::EpiGU<false> E{(bf16_t*)(ws + WS_HID0), FF0, rowss1}; gemm_phase<epi::EpiGU<false>, StaticOrder, false>(F.lds, g, S, E); }
    SEAM(6);
    if (IN(7)) { Gemm g{(const bf16_t*)(ws + WS_HID0), (const bf16_t*)(ws + WS_WDN), FF0, 0, nullptr}; StaticOrder S; S.init(T / 256, 4, F.G, bid);
        epi::EpiRes<false, DBG_STAGE == 2> E{(const void*)(ws + WS_H1), (bf16_t*)(ws + WS_H2), P.out, rowss2}; gemm_phase<epi::EpiRes<false, DBG_STAGE == 2>, StaticOrder, false>(F.lds, g, S, E); }
    SEAM(7);
#endif
#if DBG_STAGE >= 3
    if (IN(8)) { { Gemm g{(const bf16_t*)(ws + WS_H2), (const bf16_t*)(ws + WS_WQK), D, 0, nullptr}; StaticOrder S; S.init(T / 256, 5, F.G, bid);
          epi::EpiQK E{(bf16_t*)(ws + WS_Q2), (bf16_t*)(ws + WS_K2), rowss2, P.q_gain, P.k_gain}; gemm_phase<epi::EpiQK, StaticOrder, false>(F.lds, g, S, E); }
        { Gemm g{(const bf16_t*)(ws + WS_WV), (const bf16_t*)(ws + WS_H2), D, 0, nullptr}; StaticOrder S; S.init(1, T / 256, F.G, bid);
          epi::EpiVT E{(bf16_t*)(ws + WS_VT2), rowss2}; gemm_phase<epi::EpiVT, StaticOrder, false>(F.lds, g, S, E); } }
    SEAM(8);
    if (IN(9)) attn_phase(F, (const bf16_t*)(ws + WS_Q2), (const bf16_t*)(ws + WS_K2), (const bf16_t*)(ws + WS_VT2), P.rel_bias, P.sink, (bf16_t*)(ws + WS_AO));
    SEAM(9);
    if (IN(10)) { Gemm g{(const bf16_t*)(ws + WS_AO), (const bf16_t*)(ws + WS_WO), D, 0, nullptr}; StaticOrder S; S.init(T / 256, 4, F.G, bid);
        epi::EpiRes<false, true> E{(const void*)(ws + WS_H2), (bf16_t*)(ws + WS_H2), P.out, rowss3}; gemm_phase<epi::EpiRes<false, true>, StaticOrder, false>(F.lds, g, S, E); }
    SEAM(10);
#endif
#if DBG_STAGE >= 4
    if (IN(11)) router_phase(F, P.out, P.router, P.ffn_norm + D, ctl, (int*)(ws + WS_LTOK), (float*)(ws + WS_LG));
    SEAM(11);
    if (IN(12)) rowtable_phase(F, ctl, (const int*)(ws + WS_LTOK), (const float*)(ws + WS_LG), rowss3, (int*)(ws + WS_RTOK), (float*)(ws + WS_RG), (float*)(ws + WS_RRINV), (int*)(ws + WS_TILEE));
    SEAM(12);
#pragma unroll
    for (int k = 0; k < 2; ++k) {
        if (IN(13 + 2 * k)) { int ts[9]; moe_tiles(ctl, k, ts);
            Gemm g{(const bf16_t*)(ws + WS_H2), (const bf16_t*)(ws + WS_MGU), D, (size_t)2 * FFE * D, (const int*)(ws + WS_RTOK) + k * MPAD}; StaticOrder S; S.init(ts[NE], 2 * FFE / 256, F.G, bid, (const int*)(ws + WS_TILEE) + k * 512);
            epi::EpiGU<true> E{(bf16_t*)(ws + WS_HIDM), FFE, (const float*)(ws + WS_RRINV) + k * MPAD}; gemm_phase<epi::EpiGU<true>, StaticOrder, true>(F.lds, g, S, E); }
        SEAM(13 + 2 * k);
        if (IN(14 + 2 * k)) { int ts[9]; moe_tiles(ctl, k, ts);
            Gemm g{(const bf16_t*)(ws + WS_HIDM), (const bf16_t*)(ws + WS_MDN), FFE, (size_t)D * FFE, nullptr}; StaticOrder S; S.init(ts[NE], 4, F.G, bid, (const int*)(ws + WS_TILEE) + k * 512);
            epi::EpiMoeDown E{P.out, (const int*)(ws + WS_RTOK) + k * MPAD, (const float*)(ws + WS_RG) + k * MPAD}; gemm_phase<epi::EpiMoeDown, StaticOrder, false>(F.lds, g, S, E); }
        SEAM(14 + 2 * k);
    }
#endif
#undef IN
#undef SEAM
}
constexpr int N_PHASES = 17;

extern "C" void kernel_launch(void* const* d_in, const int* in_sizes, int n_in, void* d_out, int out_size, void* d_ws, size_t ws_size, hipStream_t stream) {
    static int grid = 0;
    if (grid == 0) {
        if (n_in != 22 || in_sizes[0] != T * D || out_size != T * D || ws_size < WS_END) { fprintf(stderr, "kernel_launch: unexpected shapes/workspace: n_in %d in0 %d out %d ws %zu (need %zu)\n", n_in, n_in > 0 ? in_sizes[0] : -1, out_size, ws_size, (size_t)WS_END); grid = -1; return; }
        int dev = 0, cus = 0, per_cu = 0;
        if (hipGetDevice(&dev) != hipSuccess || hipDeviceGetAttribute(&cus, hipDeviceAttributeMultiprocessorCount, dev) != hipSuccess) { fprintf(stderr, "kernel_launch: device query failed\n"); grid = -1; return; }
        if (hipFuncSetAttribute((const void*)fwd_kernel, hipFuncAttributeMaxDynamicSharedMemorySize, LDS_BYTES) != hipSuccess) { fprintf(stderr, "kernel_launch: hipFuncSetAttribute failed\n"); grid = -1; return; }
        if (hipOccupancyMaxActiveBlocksPerMultiprocessor(&per_cu, (const void*)fwd_kernel, 512, LDS_BYTES) != hipSuccess || per_cu < 1) fprintf(stderr, "kernel_launch: occupancy query reports %d blocks per CU\n", per_cu);
        (void)hipGetLastError();
        grid = cus;
    }
    if (grid < 0) return;
    if (hipMemsetAsync((char*)d_ws + WS_CTL, 0, CTL_ZERO_BYTES, stream) != hipSuccess) { fprintf(stderr, "kernel_launch: memset failed\n"); return; }
    Args a{};
    const float** pp = (const float**)&a.p;
    for (int i = 0; i < 22; ++i) pp[i] = (const float*)d_in[i];
    a.p.out = (float*)d_out; a.p.ws = (unsigned char*)d_ws;
    a.ph_lo = 0; a.ph_hi = N_PHASES;
    hipLaunchKernelGGL(fwd_kernel, dim3(grid), dim3(512), LDS_BYTES, stream, a);
    const hipError_t le = hipPeekAtLastError();
    if (le != hipSuccess) fprintf(stderr, "kernel_launch: launch failed: %s\n", hipGetErrorName(le));
}
```

```cpp
#include <hip/hip_runtime.h>
#include <cstdio>
#include <cstdint>

#define LAS __attribute__((address_space(3)))
#define GAS __attribute__((address_space(1)))
typedef unsigned short bf16_t;
typedef short bf16x8 __attribute__((ext_vector_type(8)));
typedef short s16x4 __attribute__((ext_vector_type(4)));
typedef float f32x4 __attribute__((ext_vector_type(4)));
typedef float f32x2 __attribute__((ext_vector_type(2)));
typedef float f32x16 __attribute__((ext_vector_type(16)));
typedef unsigned u32x4 __attribute__((ext_vector_type(4)));
typedef unsigned u32x2 __attribute__((ext_vector_type(2)));
typedef _Float16 f16x2 __attribute__((ext_vector_type(2)));
typedef GAS unsigned gu32;
typedef int i32x4 __attribute__((ext_vector_type(4)));
typedef int i32x8 __attribute__((ext_vector_type(8)));

constexpr int BATCH = 8, SEQ = 8192, D = 1024, T = BATCH * SEQ;
constexpr int HG_H = 8, HG_DK = 128, CHK = 64, NCHK = SEQ / CHK;
constexpr int FF0 = 2816, NE = 8, FFE = 3584;
constexpr int QH = 16, KVH = 4, HD = 64, WIN = 128;
constexpr float EPS = 1e-6f;
constexpr float LOG2E = 1.4426950408889634f;
constexpr float S8_H3 = 8.0f, S8_WGU = 64.0f, S8_HID = 8.0f, S8_WDN = 128.0f;
constexpr int MPAD = T + NE * 256;
constexpr int MAXRT = MPAD / 256;

constexpr size_t MiB = 1u << 20;
constexpr size_t WS_CTL = 0, CTL_ZERO_BYTES = 4 * MiB;
constexpr size_t WS_ROWSS1 = 1 * MiB, WS_ROWSS2 = WS_ROWSS1 + 512 * 1024, WS_ROWSS3 = WS_ROWSS2 + 512 * 1024;
constexpr size_t WS_LB = 4 * MiB;
constexpr size_t WS_INVG = 4 * MiB + 8192, WS_INVR0 = 4 * MiB + 65536;
constexpr size_t WS_DCH = 5 * MiB;
constexpr size_t WS_LTOK = 9 * MiB, WS_LG = 13 * MiB;
constexpr size_t WS_RTOK = 17 * MiB, WS_RG = 18 * MiB, WS_RRINV = 19 * MiB, WS_TILEE = 20 * MiB;
constexpr size_t WS_WQO = 24 * MiB  , WS_WFI = 26 * MiB  , WS_WOUT = 32 * MiB, WS_WGU = 34 * MiB, WS_WDN = 45 * MiB, WS_WQK = 51 * MiB, WS_WV = 54 * MiB, WS_WO = 55 * MiB;
constexpr size_t WS_MGU = 57 * MiB, WS_MDN = 169 * MiB;
constexpr size_t WS_R0 = 226 * MiB, WS_R1 = 354 * MiB, WS_R2 = 482 * MiB, WS_R3 = 866 * MiB, WS_END = 994 * MiB;
constexpr size_t WS_XN = WS_R0, WS_H2 = WS_R0;
constexpr size_t WS_Q1 = WS_R1, WS_H1 = WS_R1, WS_AO = WS_R1, WS_HIDM = WS_R1;
constexpr size_t WS_GT = WS_R2, WS_VT = WS_R2 + 128 * MiB, WS_OG1 = WS_R2 + 256 * MiB, WS_HID0 = WS_R2;
constexpr size_t WS_OGATED = WS_OG1;
constexpr size_t WS_Q2 = WS_R2, WS_K2 = WS_R2 + 128 * MiB, WS_VT2 = WS_R2 + 160 * MiB;
constexpr size_t WS_H38 = WS_R3;
constexpr size_t WS_SST = WS_R3;
static_assert(WS_HIDM + (size_t)2 * MPAD * FFE <= WS_R3, "two fp8 hid buffers fit below H38");
static_assert(WS_HID0 + (size_t)T * FF0 * 2 <= WS_R3, "HID0 fits");
constexpr int CW_BAR = 4096;
constexpr int CW_MCNT = 16384;

constexpr int RING_BYTES = 131072;
constexpr int LDS_BYTES = 163840;
constexpr int PHASE_LDS = LDS_BYTES - 1024;
constexpr int MISC_OFF = PHASE_LDS + 320;

#define LDS_WAIT() asm volatile("s_waitcnt lgkmcnt(0)" ::: "memory")
#define VM_WAIT() asm volatile("s_waitcnt vmcnt(0)" ::: "memory")
#define RLX_AGENT __ATOMIC_RELAXED, __HIP_MEMORY_SCOPE_AGENT

__device__ __forceinline__ unsigned f2bf(float f) { unsigned u = __builtin_bit_cast(unsigned, f); return (u + 0x7fffu + ((u >> 16) & 1u)) >> 16; }
__device__ __forceinline__ unsigned pk2(float lo, float hi) { return f2bf(lo) | (f2bf(hi) << 16); }
__device__ __forceinline__ unsigned cvt_pk_bf16(float lo, float hi) { unsigned r; asm volatile("v_cvt_pk_bf16_f32 %0, %1, %2" : "=v"(r) : "v"(lo), "v"(hi)); return r; }
__device__ __forceinline__ float bf_lo(unsigned w) { return __builtin_bit_cast(float, w << 16); }
__device__ __forceinline__ float bf_hi(unsigned w) { return __builtin_bit_cast(float, w & 0xffff0000u); }
__device__ __forceinline__ float bf1(bf16_t h) { return __builtin_bit_cast(float, (unsigned)h << 16); }
__device__ __forceinline__ unsigned pk_f16(float lo, float hi) { f16x2 v = {(_Float16)lo, (_Float16)hi}; return __builtin_bit_cast(unsigned, v); }
__device__ __forceinline__ unsigned pk4_fp8(float a, float b, float c, float d) { unsigned r = 0u; r = (unsigned)__builtin_amdgcn_cvt_pk_fp8_f32(a, b, (int)r, false); r = (unsigned)__builtin_amdgcn_cvt_pk_fp8_f32(c, d, (int)r, true); return r; }
__device__ __forceinline__ float clamp8(float v) { return __builtin_amdgcn_fmed3f(v, -440.0f, 440.0f); }
__device__ __forceinline__ float fast_exp(float x) { return __builtin_amdgcn_exp2f(x * LOG2E); }
__device__ __forceinline__ void fmac_s(float& acc, float a, float b) { asm("v_fmac_f32_e32 %0, %1, %2" : "+v"(acc) : "v"(a), "v"(b)); }
__device__ __forceinline__ float fast_rcp(float x) { return __builtin_amdgcn_rcpf(x); }
__device__ __forceinline__ float silu_f(float v) { return v * fast_rcp(1.0f + fast_exp(-v)); }
__device__ __forceinline__ int fresh_tid_w(int wave) { int t = wave * 64 + (int)__builtin_amdgcn_mbcnt_hi(~0u, __builtin_amdgcn_mbcnt_lo(~0u, 0u)); asm volatile("" : "+v"(t)); return t; }
#define fresh_tid() fresh_tid_w(F.wave)
__device__ __forceinline__ unsigned ld_agent(const unsigned* p) { return __hip_atomic_load((unsigned*)p, RLX_AGENT); }
typedef unsigned long long u64;
constexpr float SS_FIX = 1048576.0f;
__device__ __forceinline__ float rinv_of(u64 ssfix) { return __builtin_amdgcn_rsqf((float)ssfix * (1.0f / (SS_FIX * D)) + EPS); }

namespace pg8 {
constexpr int BM = 256, BK = 64, HALF = 128, HTB = HALF * BK * 2, STAGE_BYTES = 8 * HTB, NXCD = 8, WGM = 8;
__host__ __device__ __forceinline__ int lds_byte(int r, int c) { const int st = (r >> 4) * 2 + (c >> 5), rr = r & 15, cc = c & 31, ob = rr * 64 + cc * 2; return st * 1024 + (ob ^ (((ob >> 9) & 1) << 5)); }
__host__ __device__ __forceinline__ void stage_rc(int b, int& R, int& C) { const int st = b / 1024, sb = b % 1024, swz = sb ^ (((sb >> 9) & 1) << 5); R = (st >> 1) * 16 + swz / 64; C = (st & 1) * 32 + (swz % 64) / 2; }
__host__ __device__ __forceinline__ int perm32(int rho) { const int n = rho >> 4, i = rho & 15; return 8 * (i >> 2) + 4 * n + (i & 3); }

struct Unit { int pm, pn, e; };
struct Gemm { const bf16_t* A; const bf16_t* Bt; int K; size_t bstride  ; const int* rowtok  ; };

struct StaticOrder {
    int nM, nN, nwg, G, c; bool tiled; int ts[8];
    __device__ void init(int nM_, int nN_, int G_, int c_, const int* tstart = nullptr) { nM = nM_; nN = nN_; nwg = nM * nN; G = G_; c = c_; tiled = tstart != nullptr;
#pragma unroll
        for (int e = 0; e < 8; ++e) ts[e] = tstart ? tstart[e] : 0; }
    __device__ bool next(int i, Unit& u) const {
        const long L = (long)i * G + c; if (L >= nwg) return false;
        int wgid = (int)L; { const int q = nwg / NXCD, r = nwg % NXCD, xcd = wgid % NXCD, off = wgid / NXCD; wgid = (xcd < r ? xcd * (q + 1) : r * (q + 1) + (xcd - r) * q) + off; }
        const int nig = WGM * nN, gid = wgid / nig, fm = gid * WGM, gsz = (nM - fm) < WGM ? (nM - fm) : WGM;
        u.pm = fm + ((wgid % nig) % gsz); u.pn = (wgid % nig) / gsz;
        int e_ = 0;
        if (tiled) {
#pragma unroll
            for (int e = 1; e < 8; ++e) e_ += (u.pm >= ts[e]) ? 1 : 0; }
        u.e = e_;
        return true;
    }
};

template <class Epi, class Sched, bool GATHER, bool FP8 = false>
__device__ __forceinline__ void gemm_phase(LAS unsigned char* lds, const Gemm g, const Sched& S, const Epi& E, int wave_sgpr) {
    const int tid = fresh_tid_w(wave_sgpr), wid = __builtin_amdgcn_readfirstlane(tid >> 6), lane = tid & 63, wr = wid >> 2, wc = wid & 3, fr = lane & 15, fq = lane >> 4;
    const int K = g.K, RB = FP8 ? K : 2 * K  , nt = RB / (BK * 2);
    unsigned voffA[2], voffB[2]; int RA[2], CA[2];
#pragma unroll
    for (int i = 0; i < 2; ++i) { int R, C; stage_rc(tid * 16 + i * 8192, R, C); const int Rb = (R & ~31) + perm32(R & 31);
        RA[i] = R; CA[i] = C; voffA[i] = (unsigned)(R * RB + C * 2); voffB[i] = (unsigned)(Rb * RB + C * 2); }
    const size_t kstep = (size_t)(BK * 2);
    const size_t hstep = (size_t)HALF * RB;
    const size_t tstep = 2 * hstep;
    const unsigned ldsw = (unsigned)wid * 1024u;
    const int aoff = lds_byte(wr * 64 + fr, fq * 8), boff = lds_byte(wc * 32 + fr, fq * 8);
#define PG8_SA(b, h) (((b) * 2 + (h)) * HTB)
#define PG8_SB(b, h) ((4 + (b) * 2 + (h)) * HTB)
#define PG8_STAGE(bufoff, gbase, voff) do { _Pragma("unroll") for (int _i = 0; _i < 2; ++_i) \
        __builtin_amdgcn_global_load_lds((const unsigned*)((const char*)(gbase) + (voff)[_i]), (LAS unsigned*)(lds + (bufoff) + ldsw + _i * 8192), 16, 0, 0); } while (0)
#define PG8_STAGE_B(b, h, q) do { const bool w_ = (q) >= nt; const char* gb_ = (w_ ? nB : cB) + (size_t)(h) * hstep + (size_t)(w_ ? (q) - nt : (q)) * kstep; PG8_STAGE(PG8_SB(b, h), gb_, voffB); } while (0)
#define PG8_STAGE_A(b, h, q) do { const bool w_ = (q) >= nt; \
        if constexpr (GATHER) { const char* gb_ = (const char*)g.A + (size_t)(w_ ? (q) - nt : (q)) * kstep; unsigned go_[2]; go_[0] = w_ ? goffn[h][0] : goff[h][0]; go_[1] = w_ ? goffn[h][1] : goff[h][1]; PG8_STAGE(PG8_SA(b, h), gb_, go_); } \
        else { const char* gb_ = (w_ ? nA : cA) + (size_t)(h) * hstep + (size_t)(w_ ? (q) - nt : (q)) * kstep; PG8_STAGE(PG8_SA(b, h), gb_, voffA); } } while (0)
#define PG8_LDA(dst, b, h) do { _Pragma("unroll") for (int m = 0; m < 4; ++m) _Pragma("unroll") for (int k = 0; k < 2; ++k) dst[m][k] = *(const LAS bf16x8*)(lds + PG8_SA(b, h) + aoff + m * 2048 + k * 1024); } while (0)
#define PG8_LDB(dst, b, h) do { _Pragma("unroll") for (int n = 0; n < 2; ++n) _Pragma("unroll") for (int k = 0; k < 2; ++k) dst[n][k] = *(const LAS bf16x8*)(lds + PG8_SB(b, h) + boff + n * 2048 + k * 1024); } while (0)
#define PG8_MMA(ai, bj, At, Bt) do { __builtin_amdgcn_s_setprio(1); \
        if constexpr (FP8) { _Pragma("unroll") for (int m = 0; m < 4; ++m) _Pragma("unroll") for (int n = 0; n < 2; ++n) { \
            const i32x8 a8_ = __builtin_shufflevector(__builtin_bit_cast(i32x4, At[m][0]), __builtin_bit_cast(i32x4, At[m][1]), 0, 1, 2, 3, 4, 5, 6, 7); \
            const i32x8 b8_ = __builtin_shufflevector(__builtin_bit_cast(i32x4, Bt[n][0]), __builtin_bit_cast(i32x4, Bt[n][1]), 0, 1, 2, 3, 4, 5, 6, 7); \
            asm volatile("v_mfma_scale_f32_16x16x128_f8f6f4 %0, %1, %2, %0, %3, %3 op_sel_hi:[0,0,0]" : "+v"(acc[ai][bj][m][n]) : "v"(b8_), "v"(a8_), "v"(sc8_)); } } \
        else { _Pragma("unroll") for (int m = 0; m < 4; ++m) _Pragma("unroll") for (int n = 0; n < 2; ++n) _Pragma("unroll") for (int k = 0; k < 2; ++k) \
            acc[ai][bj][m][n] = __builtin_amdgcn_mfma_f32_16x16x32_bf16(Bt[n][k], At[m][k], acc[ai][bj][m][n], 0, 0, 0); } \
        __builtin_amdgcn_s_setprio(0); } while (0)
#define PG8_WAIT_V(n) asm volatile("s_waitcnt vmcnt(" #n ")" ::: "memory")
#define PG8_WAIT_L(n) asm volatile("s_waitcnt lgkmcnt(" #n ")" ::: "memory")
#define PG8_BAR __builtin_amdgcn_s_barrier()
#define PG8_SCHED __builtin_amdgcn_sched_barrier(0)
#define PG8_GOFF(dst, u) do { _Pragma("unroll") for (int h_ = 0; h_ < 2; ++h_) _Pragma("unroll") for (int i_ = 0; i_ < 2; ++i_) { \
        const int tk_ = g.rowtok[(u).pm * BM + h_ * HALF + RA[i_]]; dst[h_][i_] = (unsigned)((tk_ < 0 ? 0 : tk_) * RB + CA[i_] * 2); } } while (0)
    Unit cur, nxt; int ui = 0;
    if (!S.next(0, cur)) return;
    f32x4 acc[2][2][4][2];
#pragma unroll
    for (int a = 0; a < 2; ++a)
#pragma unroll
        for (int b = 0; b < 2; ++b)
#pragma unroll
            for (int m = 0; m < 4; ++m)
#pragma unroll
                for (int n = 0; n < 2; ++n) acc[a][b][m][n] = (f32x4){0.f, 0.f, 0.f, 0.f};
    bf16x8 At[4][2], B0[2][2], B1[2][2];
    const int sc8_ = 0x7f7f7f7f;
    unsigned goff[2][2], goffn[2][2];
    if constexpr (GATHER) { PG8_GOFF(goff, cur); } else { goff[0][0] = goff[0][1] = goff[1][0] = goff[1][1] = 0u; }
#pragma unroll
    for (int h_ = 0; h_ < 2; ++h_) { goffn[h_][0] = goff[h_][0]; goffn[h_][1] = goff[h_][1]; }
    const char* cA = (const char*)g.A + (GATHER ? (size_t)0 : (size_t)cur.pm * tstep);
    const char* cB = (const char*)g.Bt + ((size_t)cur.e * g.bstride) * (FP8 ? 1 : 2) + (size_t)cur.pn * tstep;
    const char* nA = cA; const char* nB = cB;
#define PG8_PRE(unit_, slot_) do { if constexpr (Epi::PRE != 0) { if (wid < Epi::PRE) \
        __builtin_amdgcn_global_load_lds((const unsigned*)((const char*)E.pre_src(unit_) + (wid * 64 + lane) * 4), (LAS unsigned*)(lds + RING_BYTES + 1024 + (slot_) * 2048 + wid * 256), 4, 0, 0); } } while (0)
    PG8_PRE(cur, 0);
    PG8_STAGE_B(0, 0, 0); PG8_STAGE_B(0, 1, 0); PG8_STAGE_A(0, 0, 0); PG8_STAGE_A(0, 1, 0);
    if (wr == 1) PG8_BAR;
    PG8_WAIT_V(2); PG8_BAR;
    PG8_STAGE_B(1, 0, 1); PG8_STAGE_A(1, 0, 1); PG8_STAGE_B(1, 1, 1);
    PG8_WAIT_V(6); PG8_BAR;
    for (;;) {
        const bool has_next = S.next(ui + 1, nxt);
        if (!has_next) nxt = cur;
        nA = (const char*)g.A + (GATHER ? (size_t)0 : (size_t)nxt.pm * tstep);
        nB = (const char*)g.Bt + ((size_t)nxt.e * g.bstride) * (FP8 ? 1 : 2) + (size_t)nxt.pn * tstep;
        if (has_next) { PG8_PRE(nxt, (ui + 1) % 3);
            if constexpr (GATHER) { if (wid < 4) __builtin_amdgcn_global_load_lds((const unsigned*)(g.rowtok + nxt.pm * BM + wid * 64 + lane), (LAS unsigned*)(lds + RING_BYTES + wid * 256), 4, 0, 0); } }
        for (int t = 0; t < nt; t += 2) {
            if constexpr (GATHER) { if (t == nt - 2 && has_next) {
#pragma unroll
                for (int h_ = 0; h_ < 2; ++h_)
#pragma unroll
                    for (int i_ = 0; i_ < 2; ++i_) { const int tk_ = *(const LAS int*)(lds + RING_BYTES + (h_ * HALF + RA[i_]) * 4); goffn[h_][i_] = (unsigned)((tk_ < 0 ? 0 : tk_) * RB + CA[i_] * 2); } } }
            PG8_LDB(B0, 0, 0); PG8_LDB(B1, 0, 1); PG8_SCHED; PG8_LDA(At, 0, 0); PG8_STAGE_A(1, 1, t + 1);
            PG8_WAIT_V(8); PG8_WAIT_L(0); PG8_BAR; PG8_MMA(0, 0, At, B0); PG8_MMA(0, 1, At, B1); PG8_BAR; PG8_SCHED;
            PG8_LDA(At, 0, 1); PG8_STAGE_B(0, 0, t + 2); PG8_STAGE_B(0, 1, t + 2); PG8_STAGE_A(0, 0, t + 2);
            PG8_WAIT_V(8); PG8_WAIT_L(0); PG8_BAR; PG8_MMA(1, 0, At, B0); PG8_MMA(1, 1, At, B1); PG8_BAR; PG8_SCHED;
            PG8_LDB(B0, 1, 0); PG8_LDB(B1, 1, 1); PG8_SCHED; PG8_LDA(At, 1, 0); PG8_STAGE_A(0, 1, t + 2);
            PG8_WAIT_V(8); PG8_WAIT_L(0); PG8_BAR; PG8_MMA(0, 0, At, B0); PG8_MMA(0, 1, At, B1); PG8_BAR; PG8_SCHED;
            PG8_LDA(At, 1, 1); PG8_STAGE_B(1, 0, t + 3); PG8_STAGE_B(1, 1, t + 3); PG8_STAGE_A(1, 0, t + 3);
            PG8_WAIT_V(8); PG8_WAIT_L(0); PG8_BAR; PG8_MMA(1, 0, At, B0); PG8_MMA(1, 1, At, B1); PG8_BAR; PG8_SCHED;
        }
        if (wr == 0) PG8_BAR;
        if constexpr (FP8) asm volatile("s_nop 15\n\ts_nop 7" ::: "memory");
        E(acc, cur, wr, wc, fr, fq, lds + RING_BYTES + 1024 + (ui % 3) * 2048);
        if (!has_next) break;
#pragma unroll
        for (int a = 0; a < 2; ++a)
#pragma unroll
            for (int b = 0; b < 2; ++b)
#pragma unroll
                for (int m = 0; m < 4; ++m)
#pragma unroll
                    for (int n = 0; n < 2; ++n) acc[a][b][m][n] = (f32x4){0.f, 0.f, 0.f, 0.f};
        cur = nxt; cA = nA; cB = nB; ++ui;
#pragma unroll
        for (int h_ = 0; h_ < 2; ++h_) { goff[h_][0] = goffn[h_][0]; goff[h_][1] = goffn[h_][1]; }
        if (wr == 1) PG8_BAR;
    }
    PG8_WAIT_V(0);
    PG8_BAR;
#undef PG8_SA
#undef PG8_SB
#undef PG8_STAGE
#undef PG8_STAGE_A
#undef PG8_STAGE_B
#undef PG8_LDA
#undef PG8_LDB
#undef PG8_MMA
#undef PG8_WAIT_V
#undef PG8_WAIT_L
#undef PG8_BAR
#undef PG8_SCHED
#undef PG8_GOFF
#undef PG8_PRE
}
}

#define XB_TMO      128
#define XB_XCNT(j)  (256  + 64 * (j))
#define XB_XSUB(j)  (1280 + 64 * (j))
#define XB_XGEN(j)  (2304 + 64 * (j))
#define XB_TOP      3328
#define XB_TOPGEN   3392
#define XCD_BAR_WORDS 3456
#define XB_SPIN_CAP (1u << 18)
__device__ __forceinline__ unsigned xb_ld(unsigned* p)              { return __hip_atomic_load(p, __ATOMIC_RELAXED, __HIP_MEMORY_SCOPE_AGENT); }
__device__ __forceinline__ unsigned xb_add(unsigned* p, unsigned v) { return __hip_atomic_fetch_add(p, v, __ATOMIC_RELAXED, __HIP_MEMORY_SCOPE_AGENT); }
__device__ __forceinline__ unsigned xb_xcc_id() { return (unsigned)__builtin_amdgcn_s_getreg((3 << 11) | 20) & 0xFu; }
#define XB_SPIN(cond, bar) do { unsigned _sp = 0; while (cond) { __builtin_amdgcn_s_sleep(1); \
    if ((++_sp & 255u) == 0u) { if (xb_ld(&(bar)[XB_TMO])) break; if (_sp > XB_SPIN_CAP) { atomicAdd(&(bar)[XB_TMO], 1u); break; } } } } while (0)
struct XcdBarrier { unsigned* bar; unsigned x; volatile LAS unsigned* st; };
__device__ __forceinline__ XcdBarrier xcd_barrier_post(unsigned* bar, volatile LAS unsigned* st) {
    XcdBarrier b; b.bar = bar; b.x = xb_xcc_id(); b.st = st;
    if (threadIdx.x == 0) (void)xb_add(&bar[XB_XCNT(b.x)], 1u);
    return b;
}
__device__ __forceinline__ void xcd_barrier_complete(unsigned* bar, unsigned x, unsigned& nloc, unsigned& nx) {
    const unsigned G = gridDim.x * gridDim.y * gridDim.z;
    unsigned sum, cnt, mine, sp = 0u;
    for (;;) {
        sum = 0u; cnt = 0u; mine = 0u;
#pragma unroll
        for (unsigned j = 0; j < 16; ++j) { const unsigned c = xb_ld(&bar[XB_XCNT(j)]); sum += c; cnt += (c > 0u) ? 1u : 0u; mine = (j == x) ? c : mine; }
        if (sum == G) break;
        __builtin_amdgcn_s_sleep(1);
        if ((++sp & 255u) == 0u) { if (xb_ld(&bar[XB_TMO])) break; if (sp > XB_SPIN_CAP) { atomicAdd(&bar[XB_TMO], 1u); break; } }
    }
    nloc = mine > 0u ? mine : 1u; nx = cnt > 0u ? cnt : 1u;
}
__device__ __forceinline__ void xcd_barrier(const XcdBarrier& b) {
    asm volatile("s_waitcnt vmcnt(0)" ::: "memory");
    __syncthreads();
    if (threadIdx.x == 0) {
        unsigned* bar = b.bar;
        __builtin_amdgcn_s_waitcnt(0);
        unsigned nloc = b.st[0], nx = b.st[1];
        if (nloc == 0u) { xcd_barrier_complete(bar, b.x, nloc, nx); b.st[0] = nloc; b.st[1] = nx; }
        const unsigned old = xb_add(&bar[XB_XSUB(b.x)], 1u);
        const unsigned gen = old / nloc;
        if (old + 1u == (gen + 1u) * nloc) {
            __builtin_amdgcn_fence(__ATOMIC_RELEASE, "agent");
            asm volatile("s_waitcnt vmcnt(0)" ::: "memory");
            const unsigned og = xb_add(&bar[XB_TOP], 1u);
            const unsigned tg = og / nx;
            if (og + 1u == (tg + 1u) * nx) xb_add(&bar[XB_TOPGEN], 1u);
            else XB_SPIN(xb_ld(&bar[XB_TOPGEN]) == tg, bar);
            __builtin_amdgcn_fence(__ATOMIC_ACQUIRE, "agent");
            xb_add(&bar[XB_XGEN(b.x)], 1u);
            asm volatile("s_waitcnt vmcnt(0)" ::: "memory");
        } else {
            XB_SPIN(xb_ld(&bar[XB_XGEN(b.x)]) == gen, bar);
            __builtin_amdgcn_fence(__ATOMIC_ACQUIRE, "agent");
            asm volatile("s_waitcnt vmcnt(0)" ::: "memory");
        }
    }
    __syncthreads();
}

struct Frame {
    LAS unsigned char* lds;
    int tid, lane, wave, vcu, G;
};
__device__ __forceinline__ float wave_sum(float v) {
#pragma unroll
    for (int o = 1; o < 64; o <<= 1) v += __shfl_xor(v, o);
    return v;
}
__device__ __forceinline__ void transpose_item(const float* W, int K, int N, int k0, int nsrc0, bf16_t* WT, int drow0, const float* gain, LAS float* scr, int lane) {
    f32x4 ld[8];
#pragma unroll
    for (int i = 0; i < 8; ++i) ld[i] = *(const f32x4*)(W + (size_t)(k0 + 8 * i + (lane >> 3)) * N + nsrc0 + 4 * (lane & 7));
#pragma unroll
    for (int i = 0; i < 8; ++i) { const int kk = 8 * i + (lane >> 3); f32x4 v = ld[i]; if (gain) v *= gain[k0 + kk]; LAS float* d = scr + kk * 33 + 4 * (lane & 7); d[0] = v[0]; d[1] = v[1]; d[2] = v[2]; d[3] = v[3]; }
    LDS_WAIT(); asm volatile("" ::: "memory");
    const int c = lane & 7;
#pragma unroll
    for (int j = 0; j < 4; ++j) { const int n = (lane >> 3) + 8 * j; const LAS float* s = scr + (8 * c) * 33 + n;
        u32x4 o; o.x = pk2(s[0 * 33], s[1 * 33]); o.y = pk2(s[2 * 33], s[3 * 33]); o.z = pk2(s[4 * 33], s[5 * 33]); o.w = pk2(s[6 * 33], s[7 * 33]);
        *(GAS u32x4*)(WT + (size_t)(drow0 + n) * K + k0 + 8 * c) = o; }
    LDS_WAIT(); asm volatile("" ::: "memory");
}
__device__ __forceinline__ void transpose_item8(const float* W, int K, int N, int k0, int nsrc0, unsigned char* WT, int drow0, const float* gain, float scale, LAS float* scr, int lane) {
    f32x4 ld[8];
#pragma unroll
    for (int i = 0; i < 8; ++i) ld[i] = *(const f32x4*)(W + (size_t)(k0 + 8 * i + (lane >> 3)) * N + nsrc0 + 4 * (lane & 7));
#pragma unroll
    for (int i = 0; i < 8; ++i) { const int kk = 8 * i + (lane >> 3); f32x4 v = ld[i] * scale; if (gain) v *= gain[k0 + kk]; LAS float* d = scr + kk * 33 + 4 * (lane & 7); d[0] = v[0]; d[1] = v[1]; d[2] = v[2]; d[3] = v[3]; }
    LDS_WAIT(); asm volatile("" ::: "memory");
    const int c = lane & 7;
#pragma unroll
    for (int j = 0; j < 4; ++j) { const int n = (lane >> 3) + 8 * j; const LAS float* s = scr + (8 * c) * 33 + n;
        u32x2 o; o.x = pk4_fp8(s[0 * 33], s[1 * 33], s[2 * 33], s[3 * 33]); o.y = pk4_fp8(s[4 * 33], s[5 * 33], s[6 * 33], s[7 * 33]);
        *(GAS u32x2*)(WT + (size_t)(drow0 + n) * K + k0 + 8 * c) = o; }
    LDS_WAIT(); asm volatile("" ::: "memory");
}
template <int MAP>
__device__ __forceinline__ void transpose_mat(const float* W, int K, int N, int ncol0, int ncols, bf16_t* WT, int roff, const float* gain, LAS float* scr, int lane, int it) {
    const int nblk = ncols / 32, kb = it / nblk, nb = it % nblk, n = 32 * nb;
    int drow;
    if (MAP == 0) drow = roff + n;
    else if (MAP == 1) drow = (n / 128) * 256 + roff + (n % 128);
    else { const int head = n / 64, d = n % 64; drow = roff + (head / 4) * 256 + (d / 32) * 128 + (head % 4) * 32; }
    transpose_item(W, K, N, 64 * kb, ncol0 + n, WT, drow, gain, scr, lane);
}

namespace epi {
using pg8::Unit;
#define EPI_ARGS const f32x4 (&acc)[2][2][4][2], const Unit& u, int wr, int wc, int fr, int fq, const LAS unsigned char* pre
__device__ __forceinline__ u32x4 pack8(f32x4 v0, f32x4 v1) { u32x4 w; w.x = cvt_pk_bf16(v0[0], v0[1]); w.y = cvt_pk_bf16(v0[2], v0[3]); w.z = cvt_pk_bf16(v1[0], v1[1]); w.w = cvt_pk_bf16(v1[2], v1[3]); return w; }
__device__ __forceinline__ void unpack8(u32x4 w, f32x4& v0, f32x4& v1) { v0 = (f32x4){bf_lo(w.x), bf_hi(w.x), bf_lo(w.y), bf_hi(w.y)}; v1 = (f32x4){bf_lo(w.z), bf_hi(w.z), bf_lo(w.w), bf_hi(w.w)}; }
__device__ __forceinline__ f32x4 silu4(f32x4 v) { return (f32x4){silu_f(v[0]), silu_f(v[1]), silu_f(v[2]), silu_f(v[3])}; }
__device__ __forceinline__ float sumsq4(f32x4 v) { return (v[0] * v[0] + v[1] * v[1]) + (v[2] * v[2] + v[3] * v[3]); }

struct EpiOG {
    static constexpr int PRE = 0;
    bf16_t* OG1;
    __device__ __forceinline__ void operator()(EPI_ARGS) const {
        const int colt = u.pn * 256 + wc * 32 + 8 * fq;
#pragma unroll
        for (int ai = 0; ai < 2; ++ai)
#pragma unroll
            for (int m = 0; m < 4; ++m) { bf16_t* rowp = OG1 + (size_t)(u.pm * 256 + ai * 128 + wr * 64 + m * 16 + fr) * D + colt;
#pragma unroll
                for (int bj = 0; bj < 2; ++bj) *(u32x4*)(rowp + bj * 128) = pack8(silu4(acc[ai][bj][m][0]), silu4(acc[ai][bj][m][1])); }
    }
};
struct EpiQFI {
    static constexpr int PRE = 0;
    unsigned short* base3; const float* LB;
    __device__ __forceinline__ void operator()(EPI_ARGS) const {
        const int kind = u.pm >> 2; unsigned short* base = base3 + (size_t)kind * (size_t)(64u << 20);
        const size_t toff = (size_t)(u.pn * 4 + (wc >> 1)) * 65536 + (wc & 1) * 32 + 8 * fq;
        if (kind == 1) { float lbr[2][4];
#pragma unroll
            for (int ai = 0; ai < 2; ++ai)
#pragma unroll
                for (int m = 0; m < 4; ++m) lbr[ai][m] = LB[(u.pm & 3) * 256 + ai * 128 + wr * 64 + m * 16 + fr];
#pragma unroll
            for (int ai = 0; ai < 2; ++ai)
#pragma unroll
                for (int m = 0; m < 4; ++m) { const int ch = (u.pm & 3) * 256 + ai * 128 + wr * 64 + m * 16 + fr; unsigned short* rowp = base + toff + (size_t)ch * 64; const float lb = lbr[ai][m], om = 1.0f - lb;
#pragma unroll
                    for (int bj = 0; bj < 2; ++bj) { u32x4 w;
#pragma unroll
                        for (int n = 0; n < 2; ++n) { const f32x4 t = __builtin_elementwise_min(acc[ai][bj][m][n] * (-LOG2E), (f32x4){80.f, 80.f, 80.f, 80.f});
                            const f32x4 e = {__builtin_amdgcn_exp2f(t[0]), __builtin_amdgcn_exp2f(t[1]), __builtin_amdgcn_exp2f(t[2]), __builtin_amdgcn_exp2f(t[3])};
                            const f32x4 a1 = e * lb + 1.0f, a2 = e + 1.0f;
                            const f32x4 l1 = {__builtin_amdgcn_logf(a1[0]), __builtin_amdgcn_logf(a1[1]), __builtin_amdgcn_logf(a1[2]), __builtin_amdgcn_logf(a1[3])};
                            const f32x4 l2 = {__builtin_amdgcn_logf(a2[0]), __builtin_amdgcn_logf(a2[1]), __builtin_amdgcn_logf(a2[2]), __builtin_amdgcn_logf(a2[3])};
                            const f32x4 g = (l1 - l2) * 0.6931471805599453f; (void)om;
                            w[2 * n] = pk_f16(g[0], g[1]); w[2 * n + 1] = pk_f16(g[2], g[3]); }
                        *(u32x4*)(rowp + bj * 131072) = w; } } }
        else {
#pragma unroll
            for (int ai = 0; ai < 2; ++ai)
#pragma unroll
                for (int m = 0; m < 4; ++m) { const int ch = (u.pm & 3) * 256 + ai * 128 + wr * 64 + m * 16 + fr; unsigned short* rowp = base + toff + (size_t)ch * 64;
#pragma unroll
                    for (int bj = 0; bj < 2; ++bj) *(u32x4*)(rowp + bj * 131072) = pack8(acc[ai][bj][m][0], acc[ai][bj][m][1]); } }
    }
};
template <int BASE, bool OUT32, bool OUT8 = false> struct EpiRes {
    static constexpr int PRE = 0;
    static constexpr bool BASE32 = BASE == 1;
    const void* base; bf16_t* out; float* out32; u64* rowss; unsigned char* out8; const float* invr; const float* invg;
    __device__ __forceinline__ void operator()(EPI_ARGS) const {
        const int colt = u.pn * 256 + wc * 32 + 8 * fq; float ssr[2][4];
        constexpr int MB = BASE32 ? 2 : 4;
        f32x4 ig[2][2]; float irr[2][4];
        if (BASE == 2) {
#pragma unroll
            for (int bj = 0; bj < 2; ++bj) { ig[bj][0] = *(const f32x4*)(invg + colt + bj * 128); ig[bj][1] = *(const f32x4*)(invg + colt + bj * 128 + 4); }
#pragma unroll
            for (int ai = 0; ai < 2; ++ai)
#pragma unroll
                for (int m = 0; m < 4; ++m) irr[ai][m] = invr[u.pm * 256 + ai * 128 + wr * 64 + m * 16 + fr]; }
#pragma unroll
        for (int ai = 0; ai < 2; ++ai)
#pragma unroll
            for (int m0 = 0; m0 < 4; m0 += MB) { u32x4 bw[MB][2][BASE32 ? 2 : 1];
#pragma unroll
                for (int mi = 0; mi < MB; ++mi) { const size_t off = (size_t)(u.pm * 256 + ai * 128 + wr * 64 + (m0 + mi) * 16 + fr) * D + colt;
#pragma unroll
                    for (int bj = 0; bj < 2; ++bj) {
                        if (BASE32) { const float* bp = (const float*)base + off + bj * 128; bw[mi][bj][0] = *(const u32x4*)bp; bw[mi][bj][BASE32 ? 1 : 0] = *(const u32x4*)(bp + 4); }
                        else bw[mi][bj][0] = *(const u32x4*)((const bf16_t*)base + off + bj * 128); } }
#pragma unroll
                for (int mi = 0; mi < MB; ++mi) { const int m = m0 + mi; const size_t off = (size_t)(u.pm * 256 + ai * 128 + wr * 64 + m * 16 + fr) * D + colt; float ss = 0.f;
#pragma unroll
                    for (int bj = 0; bj < 2; ++bj) { f32x4 b0, b1;
                        if (BASE32) { b0 = __builtin_bit_cast(f32x4, bw[mi][bj][0]); b1 = __builtin_bit_cast(f32x4, bw[mi][bj][BASE32 ? 1 : 0]); }
                        else unpack8(bw[mi][bj][0], b0, b1);
                        if (BASE == 2) { const float ir = irr[ai][m]; b0 = b0 * ir * ig[bj][0]; b1 = b1 * ir * ig[bj][1]; }
                        const f32x4 h0 = acc[ai][bj][m][0] + b0, h1 = acc[ai][bj][m][1] + b1; ss += sumsq4(h0) + sumsq4(h1);
                        *(u32x4*)(out + off + bj * 128) = pack8(h0, h1);
                        if (OUT8) { u32x2 w8; w8.x = pk4_fp8(h0[0] * S8_H3, h0[1] * S8_H3, h0[2] * S8_H3, h0[3] * S8_H3); w8.y = pk4_fp8(h1[0] * S8_H3, h1[1] * S8_H3, h1[2] * S8_H3, h1[3] * S8_H3); *(u32x2*)(out8 + off + bj * 128) = w8; }
                        if (OUT32) { float* op = out32 + off + bj * 128; *(f32x4*)op = h0; *(f32x4*)(op + 4) = h1; } }
                    ss += __shfl_xor(ss, 16); ss += __shfl_xor(ss, 32); ssr[ai][m] = ss; } }
        if (fq == 0) {
#pragma unroll
            for (int ai = 0; ai < 2; ++ai)
#pragma unroll
                for (int m = 0; m < 4; ++m) __hip_atomic_fetch_add(rowss + u.pm * 256 + ai * 128 + wr * 64 + m * 16 + fr, (u64)(ssr[ai][m] * SS_FIX), RLX_AGENT); }
    }
};
template <bool MOE> struct EpiGU {
    static constexpr int PRE = 0;
    __device__ __forceinline__ const void* pre_src(const Unit& u) const { return MOE ? (const void*)((const float*)rsrc + u.pm * 256) : (const void*)((const u64*)rsrc + u.pm * 256); }
    bf16_t* hid; int ldh; const void* rsrc;
    __device__ __forceinline__ void operator()(EPI_ARGS) const {
        const int colt = u.pn * 128 + wc * 32 + 8 * fq; float rr[2][4];
#pragma unroll
        for (int ai = 0; ai < 2; ++ai)
#pragma unroll
            for (int m = 0; m < 4; ++m) { const int rl = ai * 128 + wr * 64 + m * 16 + fr; const int row = u.pm * 256 + rl; (void)pre; rr[ai][m] = MOE ? ((const float*)rsrc)[row] : rinv_of(((const u64*)rsrc)[row]); }
#pragma unroll
        for (int ai = 0; ai < 2; ++ai)
#pragma unroll
            for (int m = 0; m < 4; ++m) { const int row = u.pm * 256 + ai * 128 + wr * 64 + m * 16 + fr;
                const float r = rr[ai][m];
                const float c1 = r * r * (MOE ? S8_HID : 1.0f), c2 = -r * LOG2E; f32x4 o[2];
#pragma unroll
                for (int n = 0; n < 2; ++n) { const f32x4 ga = acc[ai][0][m][n]; const f32x4 p = ga * acc[ai][1][m][n] * c1; const f32x4 t = ga * c2;
                    f32x4 e = {__builtin_amdgcn_exp2f(t[0]), __builtin_amdgcn_exp2f(t[1]), __builtin_amdgcn_exp2f(t[2]), __builtin_amdgcn_exp2f(t[3])}; e = e + 1.0f;
                    const f32x4 sg = {fast_rcp(e[0]), fast_rcp(e[1]), fast_rcp(e[2]), fast_rcp(e[3])}; o[n] = p * sg; }
                if (MOE) { u32x2 w8; w8.x = pk4_fp8(clamp8(o[0][0]), clamp8(o[0][1]), clamp8(o[0][2]), clamp8(o[0][3]));
                    w8.y = pk4_fp8(clamp8(o[1][0]), clamp8(o[1][1]), clamp8(o[1][2]), clamp8(o[1][3])); *(u32x2*)((unsigned char*)hid + (size_t)row * ldh + colt) = w8; }
                else *(u32x4*)(hid + (size_t)row * ldh + colt) = pack8(o[0], o[1]); }
    }
};
struct EpiQK {
    static constexpr int PRE = 0;
    bf16_t* Q2; bf16_t* K2; const u64* rowss; const float* qgain; const float* kgain;
    __device__ __forceinline__ void operator()(EPI_ARGS) const {
        const bool isq = u.pn < 4; const float* gn = isq ? qgain : kgain; const float osc = isq ? 0.125f * LOG2E : 1.0f;
        f32x4 gv[2][2];
#pragma unroll
        for (int bj = 0; bj < 2; ++bj)
#pragma unroll
            for (int n = 0; n < 2; ++n) gv[bj][n] = *(const f32x4*)(gn + 32 * bj + 8 * fq + 4 * n) * osc;
        bf16_t* base = isq ? Q2 + (size_t)(4 * u.pn + wc) * 64 + 8 * fq : K2 + (size_t)wc * 64 + 8 * fq; const int ld = isq ? D : 256; float rr[2][4];
#pragma unroll
        for (int ai = 0; ai < 2; ++ai)
#pragma unroll
            for (int m = 0; m < 4; ++m) rr[ai][m] = rinv_of(rowss[u.pm * 256 + ai * 128 + wr * 64 + m * 16 + fr]);
#pragma unroll
        for (int ai = 0; ai < 2; ++ai)
#pragma unroll
            for (int m = 0; m < 4; ++m) { const int row = u.pm * 256 + ai * 128 + wr * 64 + m * 16 + fr;
                const float r = rr[ai][m];
                f32x4 y[2][2]; float ss = 0.f;
#pragma unroll
                for (int bj = 0; bj < 2; ++bj)
#pragma unroll
                    for (int n = 0; n < 2; ++n) { y[bj][n] = acc[ai][bj][m][n] * r; ss += sumsq4(y[bj][n]); }
                ss += __shfl_xor(ss, 16); ss += __shfl_xor(ss, 32);
                const float s = __builtin_amdgcn_rsqf(ss * (1.0f / HD) + EPS);
#pragma unroll
                for (int bj = 0; bj < 2; ++bj) *(u32x4*)(base + (size_t)row * ld + 32 * bj) = pack8(y[bj][0] * s * gv[bj][0], y[bj][1] * s * gv[bj][1]); }
    }
};
struct EpiVT {
    static constexpr int PRE = 0;
    bf16_t* VT2; const u64* rowss;
    __device__ __forceinline__ void operator()(EPI_ARGS) const {
        const int tcol = u.pn * 256 + wc * 32 + 8 * fq; f32x4 rv[2][2];
#pragma unroll
        for (int bj = 0; bj < 2; ++bj)
#pragma unroll
            for (int n = 0; n < 2; ++n) {
#pragma unroll
                for (int i = 0; i < 4; ++i) rv[bj][n][i] = rinv_of(rowss[tcol + bj * 128 + 4 * n + i]); }
        const size_t toff = (size_t)(u.pn * 4 + (wc >> 1)) * 16384 + (wc & 1) * 32 + 8 * fq;
#pragma unroll
        for (int ai = 0; ai < 2; ++ai)
#pragma unroll
            for (int m = 0; m < 4; ++m) { const int ch = ai * 128 + wr * 64 + m * 16 + fr; bf16_t* rowp = VT2 + toff + (size_t)ch * 64;
#pragma unroll
                for (int bj = 0; bj < 2; ++bj) *(u32x4*)(rowp + bj * 32768) = pack8(acc[ai][bj][m][0] * rv[bj][0], acc[ai][bj][m][1] * rv[bj][1]); }
    }
};
template <bool FIRST> struct EpiMoeDown {
    static constexpr int PRE = 0;
    float* out; const int* rtok; const float* rg; bf16_t* h3b; unsigned char* dummy;
    __device__ __forceinline__ void operator()(EPI_ARGS) const {
        const int colt = u.pn * 256 + wc * 32 + 8 * fq; int tk[2][4]; float gt[2][4];
#pragma unroll
        for (int ai = 0; ai < 2; ++ai)
#pragma unroll
            for (int m = 0; m < 4; ++m) { const int prow = u.pm * 256 + ai * 128 + wr * 64 + m * 16 + fr; tk[ai][m] = rtok[prow]; gt[ai][m] = rg[prow]; }
#pragma unroll
        for (int ai = 0; ai < 2; ++ai) { u32x4 bw[4][2];
#pragma unroll
            for (int m = 0; m < 4; ++m) { const int tok = tk[ai][m]; const size_t off = (size_t)(tok < 0 ? 0 : tok) * D + colt;
#pragma unroll
                for (int bj = 0; bj < 2; ++bj) bw[m][bj] = *(const u32x4*)(h3b + off + bj * 128); }
#pragma unroll
            for (int m = 0; m < 4; ++m) { const int tok = tk[ai][m]; const float g = gt[ai][m]; const size_t off = (size_t)(tok < 0 ? 0 : tok) * D + colt;
                bf16_t* pb = tok < 0 ? (bf16_t*)dummy + (colt & 1023) : h3b + off; float* pf = tok < 0 ? (float*)dummy + (colt & 1023) : out + off;
#pragma unroll
                for (int bj = 0; bj < 2; ++bj) { f32x4 o0, o1; unpack8(bw[m][bj], o0, o1); o0 += acc[ai][bj][m][0] * g; o1 += acc[ai][bj][m][1] * g;
                    if (FIRST) *(u32x4*)(pb + bj * 128) = pack8(o0, o1);
                    else { float* p = pf + bj * 128; *(f32x4*)p = o0; *(f32x4*)(p + 4) = o1; } } } }
    }
};
#undef EPI_ARGS
}

struct Ptrs {
    const float *x, *w_in, *hlb, *gnorm, *w_out, *w_q, *q_gain, *sink, *w_o, *kv_norm, *kv_w, *k_gain, *rel_bias, *attn_norm, *ffn_norm, *ffn_wg, *ffn_wu, *ffn_wd, *router, *moe_wg, *moe_wu, *moe_wd;
    float* out; unsigned char* ws;
};
__device__ __forceinline__ void p0_prologue(Frame& F, const Ptrs& P) {
    unsigned char* ws = P.ws;
    const int tid_ = fresh_tid(), lane = tid_ & 63, wave_ = __builtin_amdgcn_readfirstlane(tid_ >> 6);
    LAS float* scr = (LAS float*)(F.lds + wave_ * 16384);
    const int gw = F.vcu * 8 + wave_, NGW = F.G * 8;
    constexpr int I_QO = 16 * 32, I_FI = 16 * 96, I_OUT = 16 * 32, I_G = 16 * 88, I_DN = 44 * 32, I_Q = 16 * 32, I_KV = 16 * 16, I_O = 16 * 32;
    constexpr int I_MG = 16 * 112, I_MD = 56 * 32;
    constexpr int N_SMALL = I_QO + I_FI + I_OUT + 2 * I_G + I_DN + I_Q + I_KV + I_O;
    constexpr int N_MOE = NE * (2 * I_MG + I_MD);
    struct TItem { const float* src; int K, N, k0, drow0, fp8; unsigned char* dst; const float* gain; float scale; };
    auto decode = [&](int it) -> TItem {
        TItem t; t.gain = nullptr; t.scale = 1.0f; t.fp8 = 0; int r = it;
#define TI_SET(W_, K_, N_, kb_, nsrc_, dst_, drow_) do { t.src = (W_) + (nsrc_); t.K = (K_); t.N = (N_); t.k0 = 64 * (kb_); t.dst = (unsigned char*)(dst_); t.drow0 = (drow_); } while (0)
        if (r < I_QO) { const int kb = r / 32, n = 32 * (r % 32); TI_SET(P.w_in, D, 4 * D, kb, 3072 + n, ws + WS_WQO, n); return t; } r -= I_QO;
        if (r < I_FI) { const int kb = r / 96, n = 32 * (r % 96); TI_SET(P.w_in, D, 4 * D, kb, n, ws + WS_WFI, n); return t; } r -= I_FI;
        if (r < I_OUT) { const int kb = r / 32, n = 32 * (r % 32); TI_SET(P.w_out, D, D, kb, n, ws + WS_WOUT, n); return t; } r -= I_OUT;
        if (r < 2 * I_G) { const bool up = r >= I_G; if (up) r -= I_G; const int kb = r / 88, n = 32 * (r % 88);
            TI_SET(up ? P.ffn_wu : P.ffn_wg, D, FF0, kb, n, ws + WS_WGU, (n / 128) * 256 + (up ? 128 : 0) + (n % 128)); t.gain = P.ffn_norm; return t; } r -= 2 * I_G;
        if (r < I_DN) { const int kb = r / 32, n = 32 * (r % 32); TI_SET(P.ffn_wd, FF0, D, kb, n, ws + WS_WDN, n); return t; } r -= I_DN;
        if (r < I_Q) { const int kb = r / 32, n = 32 * (r % 32), head = n / 64, d = n % 64;
            TI_SET(P.w_q, D, D, kb, n, ws + WS_WQK, (head / 4) * 256 + (d / 32) * 128 + (head % 4) * 32); t.gain = P.attn_norm + D; return t; } r -= I_Q;
        if (r < I_KV) { const int kb = r / 16, n = 32 * (r % 16);
            if (n < 256) { const int head = n / 64, d = n % 64; TI_SET(P.kv_w, D, 512, kb, n, ws + WS_WQK, 1024 + (d / 32) * 128 + head * 32); }
            else TI_SET(P.kv_w, D, 512, kb, n, ws + WS_WV, n - 256);
            t.gain = P.kv_norm; return t; } r -= I_KV;
        if (r < I_O) { const int kb = r / 32, n = 32 * (r % 32); TI_SET(P.w_o, D, D, kb, n, ws + WS_WO, n); return t; } r -= I_O;
        const int e = r / (2 * I_MG + I_MD); r -= e * (2 * I_MG + I_MD); t.fp8 = 1;
        if (r < 2 * I_MG) { const bool up = r >= I_MG; if (up) r -= I_MG; const int kb = r / (FFE / 32), n = 32 * (r % (FFE / 32));
            TI_SET((up ? P.moe_wu : P.moe_wg) + (size_t)e * D * FFE, D, FFE, kb, n, ws + WS_MGU + (size_t)e * 2 * FFE * D, (n / 128) * 256 + (up ? 128 : 0) + (n % 128)); t.gain = P.ffn_norm + D; t.scale = S8_WGU; return t; } r -= 2 * I_MG;
        { const int kb = r / 32, n = 32 * (r % 32); TI_SET(P.moe_wd + (size_t)e * FFE * D, FFE, D, kb, n, ws + WS_MDN + (size_t)e * D * FFE, n); t.scale = S8_WDN; }
#undef TI_SET
        return t; };
#define TI_LOAD(t_, ld_) do { _Pragma("unroll") for (int i_ = 0; i_ < 8; ++i_) ld_[i_] = *(const f32x4*)((t_).src + (size_t)((t_).k0 + 8 * i_ + (lane >> 3)) * (t_).N + 4 * (lane & 7)); } while (0)
    f32x4 ldc[8], ldn[8];
    int it = gw; TItem cur{}; if (it < N_SMALL + N_MOE) { cur = decode(it); TI_LOAD(cur, ldc); }
    for (; it < N_SMALL + N_MOE; it += NGW) {
        const bool more = it + NGW < N_SMALL + N_MOE; TItem nxt = cur;
        if (more) { nxt = decode(it + NGW); TI_LOAD(nxt, ldn); }
#pragma unroll
        for (int i = 0; i < 8; ++i) { const int kk = 8 * i + (lane >> 3); f32x4 v = ldc[i] * cur.scale; if (cur.gain) v *= cur.gain[cur.k0 + kk]; LAS float* d = scr + kk * 33 + 4 * (lane & 7); d[0] = v[0]; d[1] = v[1]; d[2] = v[2]; d[3] = v[3]; }
        LDS_WAIT(); asm volatile("" ::: "memory");
        { const int c = lane & 7;
#pragma unroll
          for (int j = 0; j < 4; ++j) { const int n = (lane >> 3) + 8 * j; const LAS float* sp = scr + (8 * c) * 33 + n;
              if (cur.fp8) { u32x2 o; o.x = pk4_fp8(sp[0 * 33], sp[1 * 33], sp[2 * 33], sp[3 * 33]); o.y = pk4_fp8(sp[4 * 33], sp[5 * 33], sp[6 * 33], sp[7 * 33]);
                  *(GAS u32x2*)(cur.dst + (size_t)(cur.drow0 + n) * cur.K + cur.k0 + 8 * c) = o; }
              else { u32x4 o; o.x = pk2(sp[0 * 33], sp[1 * 33]); o.y = pk2(sp[2 * 33], sp[3 * 33]); o.z = pk2(sp[4 * 33], sp[5 * 33]); o.w = pk2(sp[6 * 33], sp[7 * 33]);
                  *(GAS u32x4*)((bf16_t*)cur.dst + (size_t)(cur.drow0 + n) * cur.K + cur.k0 + 8 * c) = o; } } }
        LDS_WAIT(); asm volatile("" ::: "memory");
        cur = nxt;
#pragma unroll
        for (int i = 0; i < 8; ++i) ldc[i] = ldn[i];
    }
#undef TI_LOAD
    if (blockIdx.x == 0) { for (int c = tid_; c < D; c += 512) { ((float*)(ws + WS_INVG))[c] = 1.0f / P.attn_norm[c]; const float a = P.hlb[c], b = P.hlb[D + c], d = P.hlb[2 * D + c]; const float mx = fmaxf(a, fmaxf(b, d));
        const float ea = __expf(a - mx), eb = __expf(b - mx), ed = __expf(d - mx); ((float*)(ws + WS_LB))[c] = ea / (ea + eb + ed); } }
    bf16_t* XN = (bf16_t*)(ws + WS_XN);
    f32x4 gn[4];
#pragma unroll
    for (int j = 0; j < 4; ++j) gn[j] = ((const f32x4*)P.attn_norm)[lane + 64 * j];
    for (int m = 2 * gw; m < T; m += 2 * NGW) {
        f32x4 v[2][4]; float sq[2];
#pragma unroll
        for (int rr = 0; rr < 2; ++rr) { const GAS f32x4* xr = (const GAS f32x4*)(P.x + (size_t)(m + rr) * D) + lane;
#pragma unroll
            for (int j = 0; j < 4; ++j) v[rr][j] = xr[64 * j]; }
#pragma unroll
        for (int rr = 0; rr < 2; ++rr) { float a = 0.f;
#pragma unroll
            for (int j = 0; j < 4; ++j) a += (v[rr][j][0] * v[rr][j][0] + v[rr][j][1] * v[rr][j][1]) + (v[rr][j][2] * v[rr][j][2] + v[rr][j][3] * v[rr][j][3]);
            sq[rr] = a; }
#pragma unroll
        for (int o = 1; o < 64; o <<= 1) { sq[0] += __shfl_xor(sq[0], o); sq[1] += __shfl_xor(sq[1], o); }
#pragma unroll
        for (int rr = 0; rr < 2; ++rr) { const float r = __builtin_amdgcn_rsqf(sq[rr] * (1.f / D) + EPS); if (lane == 0) ((float*)(ws + WS_INVR0))[m + rr] = 1.0f / r;
            GAS u32x2* o8 = (GAS u32x2*)(XN + (size_t)(m + rr) * D) + lane;
#pragma unroll
            for (int j = 0; j < 4; ++j) { const f32x4 y = v[rr][j] * r * gn[j]; u32x2 w; w.x = cvt_pk_bf16(y[0], y[1]); w.y = cvt_pk_bf16(y[2], y[3]); o8[64 * j] = w; } }
    }
}

__device__ __forceinline__ void scan_state_pass(Frame& F, const unsigned short* GT, const bf16_t* VT, float* SST) {
    constexpr int KP = 144, L_K = 0, L_V = 32 * KP, L_D = L_V + 128 * KP, BUF = L_D + 128;
    LAS unsigned char* lds = F.lds;
    const int tid = fresh_tid(), lane = tid & 63, w = __builtin_amdgcn_readfirstlane(tid >> 6), l15 = lane & 15, g = lane >> 4, ch = tid >> 4, sg = tid & 15;
    for (int item = F.vcu; item < BATCH * HG_H * 4; item += F.G) {
        const int bh = item >> 2, kq = item & 3, b = bh >> 3, h = bh & 7;
        const size_t blk0 = (size_t)b * NCHK;
        const unsigned short* gsrc = GT + (blk0 * 1024 + h * 128 + 32 * kq + ch) * 64 + 4 * sg;
        const bf16_t* vsrc = VT + (blk0 * 1024 + h * 128) * 64 + (size_t)tid * 8;
        u32x2 rg[2]; u32x4 rv[2][2];
#define SP_LOAD(set, cc) do { rg[set] = *(const u32x2*)(gsrc + (size_t)(cc) * 65536); rv[set][0] = *(const u32x4*)(vsrc + (size_t)(cc) * 65536); rv[set][1] = *(const u32x4*)(vsrc + (size_t)(cc) * 65536 + 4096); } while (0)
        f32x4 S[2]; S[0] = (f32x4){0.f, 0.f, 0.f, 0.f}; S[1] = S[0];
        SP_LOAD(0, 0); SP_LOAD(1, 1);
#define SP_ELEM(set, cc) do { LAS unsigned char* bf_ = lds + (set) * BUF; \
            { const unsigned w0_ = rg[set].x, w1_ = rg[set].y;   const f16x2 p0 = __builtin_bit_cast(f16x2, w0_), p1 = __builtin_bit_cast(f16x2, w1_); const float gl0 = (float)p0[0], gl1 = (float)p0[1], gl2 = (float)p1[0], gl3 = (float)p1[1]; \
              const float c0 = gl0, c1 = c0 + gl1, c2 = c1 + gl2, c3 = c2 + gl3; float inc = c3; \
              _Pragma("unroll") for (int o_ = 1; o_ < 16; o_ <<= 1) { const float up = __shfl_up(inc, o_, 16); if (sg >= o_) inc += up; } \
              const float bl = __shfl(inc, 15, 16), off = inc - c3; \
              const float k0 = (1.0f - fast_exp(gl0)) * fast_exp(bl - (off + c0)), k1 = (1.0f - fast_exp(gl1)) * fast_exp(bl - (off + c1)), k2 = (1.0f - fast_exp(gl2)) * fast_exp(bl - (off + c2)), k3 = (1.0f - fast_exp(gl3)) * fast_exp(bl - (off + c3)); \
              u32x2 kw; kw.x = cvt_pk_bf16(k0, k1); kw.y = cvt_pk_bf16(k2, k3); *(LAS u32x2*)(bf_ + L_K + ch * KP + sg * 8) = kw; \
              if (sg == 0) *(LAS float*)(bf_ + L_D + ch * 4) = fast_exp(bl); } \
            *(LAS u32x4*)(bf_ + L_V + (tid >> 3) * KP + (tid & 7) * 16) = rv[set][0]; *(LAS u32x4*)(bf_ + L_V + (64 + (tid >> 3)) * KP + (tid & 7) * 16) = rv[set][1]; \
            if ((cc) + 2 < NCHK) SP_LOAD(set, (cc) + 2); } while (0)
#define SP_MMA(set, cc) do { const LAS unsigned char* bf_ = lds + (set) * BUF; \
            _Pragma("unroll") for (int kt = 0; kt < 2; ++kt) { const f32x4 dv = *(const LAS f32x4*)(bf_ + L_D + (16 * kt + 4 * g) * 4); f32x4 cacc = S[kt] * dv; \
                _Pragma("unroll") for (int s2 = 0; s2 < 2; ++s2) { const bf16x8 a_ = *(const LAS bf16x8*)(bf_ + L_K + (16 * kt + l15) * KP + (32 * s2 + 8 * g) * 2); const bf16x8 b_ = *(const LAS bf16x8*)(bf_ + L_V + (16 * w + l15) * KP + (32 * s2 + 8 * g) * 2); \
                    cacc = __builtin_amdgcn_mfma_f32_16x16x32_bf16(a_, b_, cacc, 0, 0, 0); } \
                S[kt] = cacc; } \
            if ((((cc) & 7) == 7) && (cc) + 1 < NCHK) { float* dst = SST + (((size_t)bh * 16 + (((cc) + 1) >> 3)) * 128 + 32 * kq) * 128 + 16 * w + l15; \
                _Pragma("unroll") for (int kt = 0; kt < 2; ++kt) _Pragma("unroll") for (int r = 0; r < 4; ++r) dst[(size_t)(16 * kt + 4 * g + r) * 128] = S[kt][r]; } } while (0)
        for (int c = 0; c < NCHK; c += 2) {
            SP_ELEM(0, c); LDS_WAIT(); __syncthreads(); SP_MMA(0, c);
            SP_ELEM(1, c + 1); LDS_WAIT(); __syncthreads(); SP_MMA(1, c + 1); }
        __syncthreads();
#undef SP_LOAD
#undef SP_ELEM
#undef SP_MMA
    }
}
__device__ __forceinline__ void scan_output_pass(Frame& F, const bf16_t* QT, const unsigned short* GT, const bf16_t* VT, const float* SST, const bf16_t* OG1, const float* gnorm, bf16_t* OGATED) {
    constexpr int QP = 272, KP = 144, OP = 528, L_QE = 0, L_KE = 64 * QP, L_KD = 2 * 64 * QP, L_VT = L_KD + 128 * KP, L_O = L_VT + 128 * KP, L_D = L_O + 64 * OP, L_RED = L_D + 512;
    static_assert(L_RED + 1024 <= RING_BYTES, "scan LDS");
    LAS unsigned char* lds = F.lds;
    const int tid = fresh_tid(), lane = tid & 63, w = __builtin_amdgcn_readfirstlane(tid >> 6), l31 = lane & 31, hh = lane >> 5, ch = tid >> 2, seg = tid & 3, tt = w & 1, et = w >> 1;
    const int ft = tid >> 3, fe = tid & 7;
    for (int item = F.vcu; item < BATCH * HG_H * 16; item += F.G) {
        const int bh = item >> 4, sc = item & 15, b = bh >> 3, h = bh & 7;
        const size_t blk0 = (size_t)b * NCHK + (size_t)sc * 8;
        f32x16 S[4];
        if (sc == 0) {
#pragma unroll
            for (int kt = 0; kt < 4; ++kt) S[kt] = (f32x16){};
        } else { const float* src = SST + (((size_t)bh * 16 + sc) * 128) * 128 + 32 * et + l31;
#pragma unroll
            for (int kt = 0; kt < 4; ++kt)
#pragma unroll
                for (int r = 0; r < 16; ++r) S[kt][r] = src[(size_t)(32 * kt + (r & 3) + 8 * (r >> 2) + 4 * hh) * 128]; }
        const size_t tile0 = (blk0 * 1024 + h * 128) * 64;
        u32x4 pg[2], pq[2], pvv[2];
#define OP_LOAD(cc) do { const size_t to_ = tile0 + (size_t)(cc) * 65536; const u32x4* gp_ = (const u32x4*)(GT + to_ + ch * 64 + 16 * seg); pg[0] = gp_[0]; pg[1] = gp_[1]; \
            const u32x4* qp_ = (const u32x4*)(QT + to_ + ch * 64 + 16 * seg); pq[0] = qp_[0]; pq[1] = qp_[1]; \
            pvv[0] = *(const u32x4*)(VT + to_ + (size_t)tid * 8); pvv[1] = *(const u32x4*)(VT + to_ + (size_t)tid * 8 + 4096); } while (0)
        OP_LOAD(0);
        for (int c = 0; c < 8; ++c) {
            float gl[16], qv[16];
            { const unsigned gw_[8] = {pg[0].x, pg[0].y, pg[0].z, pg[0].w, pg[1].x, pg[1].y, pg[1].z, pg[1].w}; const unsigned qw_[8] = {pq[0].x, pq[0].y, pq[0].z, pq[0].w, pq[1].x, pq[1].y, pq[1].z, pq[1].w};
#pragma unroll
              for (int i = 0; i < 8; ++i) { const f16x2 p = __builtin_bit_cast(f16x2, gw_[i]); gl[2 * i] = (float)p[0]; gl[2 * i + 1] = (float)p[1]; qv[2 * i] = bf_lo(qw_[i]); qv[2 * i + 1] = bf_hi(qw_[i]); } }
            float cs[16]; { float a = 0.f;
#pragma unroll
              for (int i = 0; i < 16; ++i) { a += gl[i]; cs[i] = a; } }
            float inc = cs[15]; { const float u1 = __shfl_up(inc, 1, 4); if (seg >= 1) inc += u1; const float u2 = __shfl_up(inc, 2, 4); if (seg >= 2) inc += u2; }
            const float blast = __shfl(inc, 3, 4), off = inc - cs[15];
            unsigned kdw[8];
#pragma unroll
            for (int i = 0; i < 16; i += 2) { float kd2[2];
#pragma unroll
                for (int j = 0; j < 2; ++j) { const int ii = i + j; const float bt = off + cs[ii]; const float kk = 1.0f - fast_exp(gl[ii]);
                    const float qe = qv[ii] * fast_exp(bt), ke = kk * fast_exp(-fmaxf(bt, -80.f)); kd2[j] = kk * fast_exp(blast - bt);
                    const int t = 16 * seg + ii;
                    *(LAS bf16_t*)(lds + L_QE + t * QP + ch * 2) = (bf16_t)f2bf(qe); *(LAS bf16_t*)(lds + L_KE + t * QP + ch * 2) = (bf16_t)f2bf(ke); }
                kdw[i >> 1] = cvt_pk_bf16(kd2[0], kd2[1]); }
            *(LAS u32x4*)(lds + L_KD + ch * KP + seg * 32) = (u32x4){kdw[0], kdw[1], kdw[2], kdw[3]}; *(LAS u32x4*)(lds + L_KD + ch * KP + seg * 32 + 16) = (u32x4){kdw[4], kdw[5], kdw[6], kdw[7]};
            if (seg == 0) *(LAS float*)(lds + L_D + ch * 4) = fast_exp(blast);
            *(LAS u32x4*)(lds + L_VT + (tid >> 3) * KP + (tid & 7) * 16) = pvv[0]; *(LAS u32x4*)(lds + L_VT + (64 + (tid >> 3)) * KP + (tid & 7) * 16) = pvv[1];
            if (c + 1 < 8) OP_LOAD(c + 1);
            const u32x4* ogp = (const u32x4*)(OG1 + ((blk0 + c) * 64 + ft) * D + h * 128 + 16 * fe); const u32x4 og0 = ogp[0], og1 = ogp[1];
            LDS_WAIT(); __syncthreads();
            { f32x16 oacc = {};
              for (int st = 0; st <= tt; ++st) { f32x16 sacc = {};
#pragma unroll
                  for (int kk = 0; kk < 8; ++kk) { const bf16x8 a = *(const LAS bf16x8*)(lds + L_KE + (32 * st + l31) * QP + (16 * kk + 8 * hh) * 2);
                      const bf16x8 bq = *(const LAS bf16x8*)(lds + L_QE + (32 * tt + l31) * QP + (16 * kk + 8 * hh) * 2);
                      sacc = __builtin_amdgcn_mfma_f32_32x32x16_bf16(a, bq, sacc, 0, 0, 0); }
                  if (st == tt) {
#pragma unroll
                      for (int r = 0; r < 16; ++r) { const int sl = (r & 3) + 8 * (r >> 2) + 4 * hh; if (sl > l31) sacc[r] = 0.f; } }
#pragma unroll
                  for (int s2 = 0; s2 < 2; ++s2) { u32x4 pw; pw.x = cvt_pk_bf16(sacc[8 * s2 + 0], sacc[8 * s2 + 1]); pw.y = cvt_pk_bf16(sacc[8 * s2 + 2], sacc[8 * s2 + 3]);
                      pw.z = cvt_pk_bf16(sacc[8 * s2 + 4], sacc[8 * s2 + 5]); pw.w = cvt_pk_bf16(sacc[8 * s2 + 6], sacc[8 * s2 + 7]);
                      const LAS unsigned char* vb = lds + L_VT + (32 * et + l31) * KP + (32 * st + 16 * s2 + 4 * hh) * 2;
                      const u32x2 lo = *(const LAS u32x2*)vb, hi = *(const LAS u32x2*)(vb + 16); const u32x4 vw = {lo.x, lo.y, hi.x, hi.y};
                      oacc = __builtin_amdgcn_mfma_f32_32x32x16_bf16(__builtin_bit_cast(bf16x8, vw), __builtin_bit_cast(bf16x8, pw), oacc, 0, 0, 0); } }
#pragma unroll
              for (int kt = 0; kt < 4; ++kt)
#pragma unroll
                  for (int s2 = 0; s2 < 2; ++s2) { u32x4 aw; aw.x = cvt_pk_bf16(S[kt][8 * s2 + 0], S[kt][8 * s2 + 1]); aw.y = cvt_pk_bf16(S[kt][8 * s2 + 2], S[kt][8 * s2 + 3]);
                      aw.z = cvt_pk_bf16(S[kt][8 * s2 + 4], S[kt][8 * s2 + 5]); aw.w = cvt_pk_bf16(S[kt][8 * s2 + 6], S[kt][8 * s2 + 7]);
                      const LAS unsigned char* qb = lds + L_QE + (32 * tt + l31) * QP + (32 * kt + 16 * s2 + 4 * hh) * 2;
                      const u32x2 lo = *(const LAS u32x2*)qb, hi = *(const LAS u32x2*)(qb + 16); const u32x4 bw = {lo.x, lo.y, hi.x, hi.y};
                      oacc = __builtin_amdgcn_mfma_f32_32x32x16_bf16(__builtin_bit_cast(bf16x8, aw), __builtin_bit_cast(bf16x8, bw), oacc, 0, 0, 0); }
#pragma unroll
              for (int kt = 0; kt < 4; ++kt) { f32x16 cacc;
#pragma unroll
                  for (int i = 0; i < 4; ++i) { const f32x4 dv = *(const LAS f32x4*)(lds + L_D + (32 * kt + 8 * i + 4 * hh) * 4);
#pragma unroll
                      for (int j = 0; j < 4; ++j) cacc[4 * i + j] = S[kt][4 * i + j] * dv[j]; }
#pragma unroll
                  for (int ss = 0; ss < 4; ++ss) { const bf16x8 a = *(const LAS bf16x8*)(lds + L_KD + (32 * kt + l31) * KP + (16 * ss + 8 * hh) * 2);
                      const bf16x8 bv = *(const LAS bf16x8*)(lds + L_VT + (32 * et + l31) * KP + (16 * ss + 8 * hh) * 2);
                      cacc = __builtin_amdgcn_mfma_f32_32x32x16_bf16(a, bv, cacc, 0, 0, 0); }
                  S[kt] = cacc; }
              float ssq = 0.f;
#pragma unroll
              for (int r = 0; r < 16; ++r) ssq += oacc[r] * oacc[r];
              ssq += __shfl_xor(ssq, 32);
              if (hh == 0) ((LAS float*)(lds + L_RED))[et * 64 + 32 * tt + l31] = ssq;
#pragma unroll
              for (int i = 0; i < 4; ++i) *(LAS f32x4*)(lds + L_O + (32 * tt + l31) * OP + (32 * et + 8 * i + 4 * hh) * 4) = (f32x4){oacc[4 * i], oacc[4 * i + 1], oacc[4 * i + 2], oacc[4 * i + 3]}; }
            LDS_WAIT(); __syncthreads();
            { const LAS float* red = (const LAS float*)(lds + L_RED); const float rinv = __builtin_amdgcn_rsqf(((red[ft] + red[64 + ft]) + (red[128 + ft] + red[192 + ft])) * (1.0f / HG_DK) + EPS);
              f32x4 ov[4];
#pragma unroll
              for (int i = 0; i < 4; ++i) ov[i] = *(const LAS f32x4*)(lds + L_O + ft * OP + (16 * fe + 4 * i) * 4) * rinv * *(const f32x4*)(gnorm + 16 * fe + 4 * i);
              f32x4 g0, g1, g2, g3; epi::unpack8(og0, g0, g1); epi::unpack8(og1, g2, g3);
              bf16_t* dst = OGATED + ((blk0 + c) * 64 + ft) * D + h * 128 + 16 * fe;
              *(u32x4*)dst = epi::pack8(ov[0] * g0, ov[1] * g1); *(u32x4*)(dst + 8) = epi::pack8(ov[2] * g2, ov[3] * g3); }
        }
#undef OP_LOAD
    }
}

__device__ __forceinline__ void attn_phase(Frame& F, const bf16_t* Q2, const bf16_t* K2, const bf16_t* VT2, const float* rel_bias, const float* sink, bf16_t* AO) {
    constexpr int KPT = 144, VPT = 400, L_KB = 0, L_VB = 192 * KPT, ABUF = L_VB + 64 * VPT, L_BT = 2 * ABUF, L_OST = L_BT + QH * WIN * 4, OPT = 144;
    static_assert(L_OST + 8 * 32 * OPT <= PHASE_LDS, "attention LDS");
    LAS unsigned char* lds = F.lds;
    LAS float* BT = (LAS float*)(lds + L_BT);
    const int tid = fresh_tid(), lane = tid & 63, w = __builtin_amdgcn_readfirstlane(tid >> 6), l31 = lane & 31, hh = lane >> 5;
    for (int idx = tid; idx < QH * WIN; idx += 512) { const int hq = idx >> 7, n = idx & 127; int bk;
        if (n < 16) bk = n; else { bk = 16 + (int)(__logf((float)n * (1.0f / 16.0f)) / __logf(8.0f) * 16.0f); bk = bk > 31 ? 31 : bk; }
        BT[idx] = rel_bias[bk * QH + hq] * LOG2E; }
    constexpr int NITEM = BATCH * KVH * (SEQ / 64);
    u32x4 rk[3], rvv[3]; bf16x8 qf[4];
#define AT_LOAD(it_) do { const int b_ = (it_) / (KVH * (SEQ / 64)), kvh_ = ((it_) / (SEQ / 64)) % KVH, pg_ = (it_) % (SEQ / 64); const size_t rowb_ = (size_t)b_ * SEQ; \
        _Pragma("unroll") for (int i_ = 0; i_ < 3; ++i_) { const int p_ = tid + 512 * i_, kr_ = 64 * pg_ - 128 + (p_ >> 3); \
            rk[i_] = kr_ >= 0 ? *(const u32x4*)(K2 + (rowb_ + kr_) * 256 + kvh_ * HD + (p_ & 7) * 8) : (u32x4){0u, 0u, 0u, 0u}; \
            const int blk_ = pg_ - 2 + i_; rvv[i_] = blk_ >= 0 ? *(const u32x4*)(VT2 + (((size_t)b_ * (SEQ / 64) + blk_) * 256 + kvh_ * HD + (tid >> 3)) * 64 + (tid & 7) * 8) : (u32x4){0u, 0u, 0u, 0u}; } } while (0)
#define AT_LOADQ(it_) do { const int b_ = (it_) / (KVH * (SEQ / 64)), kvh_ = ((it_) / (SEQ / 64)) % KVH, pg_ = (it_) % (SEQ / 64); const size_t rowb_ = (size_t)b_ * SEQ; \
        const int hq_ = 4 * kvh_ + (w & 3), p0_ = 64 * pg_ + 32 * (w >> 2); \
        _Pragma("unroll") for (int kk = 0; kk < 4; ++kk) qf[kk] = *(const bf16x8*)(Q2 + (rowb_ + p0_ + l31) * D + hq_ * HD + 16 * kk + 8 * hh); } while (0)
#define AT_WRITE(buf_) do { LAS unsigned char* s_ = lds + (buf_) * ABUF; \
        _Pragma("unroll") for (int i_ = 0; i_ < 3; ++i_) { const int p_ = tid + 512 * i_; *(LAS u32x4*)(s_ + L_KB + (p_ >> 3) * KPT + (p_ & 7) * 16) = rk[i_]; \
            *(LAS u32x4*)(s_ + L_VB + (tid >> 3) * VPT + i_ * 128 + (tid & 7) * 16) = rvv[i_]; } } while (0)
    int it = F.vcu, buf = 0;
    if (it < NITEM) { AT_LOAD(it); AT_LOADQ(it); AT_WRITE(0); }
    LDS_WAIT(); __syncthreads();
    for (; it < NITEM; it += F.G) {
        const int b = it / (KVH * (SEQ / 64)), kvh = (it / (SEQ / 64)) % KVH, pg = it % (SEQ / 64);
        const int hq = 4 * kvh + (w & 3), wq = w >> 2, p0 = 64 * pg + 32 * wq;
        const size_t rowb = (size_t)b * SEQ;
        const LAS unsigned char* sb = lds + buf * ABUF;
        const bool more = it + F.G < NITEM;
        f32x16 s[5];
        const int j0 = p0 >= 128 ? 0 : (128 - p0) / 32;
        const float zs = sink[hq] * LOG2E; float mx = zs;
        int ib = l31 - 4 * hh; asm volatile("" : "+v"(ib));
        const LAS float* bp = BT + hq * WIN + (ib - 31);
#pragma unroll
        for (int j = 0; j < 5; ++j) {
#pragma unroll
            for (int r = 0; r < 16; ++r) s[j][r] = bp[128 - 32 * j - ((r & 3) + 8 * (r >> 2)) + 31];
#pragma unroll
            for (int kk = 0; kk < 4; ++kk) { const bf16x8 kf = *(const LAS bf16x8*)(sb + L_KB + (32 * wq + 32 * j + l31) * KPT + (16 * kk + 8 * hh) * 2);
                s[j] = __builtin_amdgcn_mfma_f32_32x32x16_bf16(kf, qf[kk], s[j], 0, 0, 0); } }
        if (more) { AT_LOADQ(it + F.G); AT_LOAD(it + F.G); }
#pragma unroll
        for (int j = 0; j < 5; ++j) { const bool jin = j >= j0;
#pragma unroll
            for (int r = 0; r < 16; ++r) { const int cr = (r & 3) + 8 * (r >> 2);
                const bool ok = jin && (j == 0 ? ib < cr : (j == 4 ? ib >= cr : true));
                const float z = ok ? s[j][r] : -INFINITY; s[j][r] = z; mx = fmaxf(mx, z); } }
        mx = fmaxf(mx, __shfl_xor(mx, 32));
        float den = 0.f;
#pragma unroll
        for (int j = 0; j < 5; ++j)
#pragma unroll
            for (int r = 0; r < 16; ++r) { const float p = __builtin_amdgcn_exp2f(s[j][r] - mx); s[j][r] = p; den += p; }
        den += __shfl_xor(den, 32); den += __builtin_amdgcn_exp2f(zs - mx);
        const float inv = fast_rcp(den);
        f32x16 o[2]; o[0] = (f32x16){}; o[1] = (f32x16){};
#pragma unroll
        for (int j = 0; j < 5; ++j) { {
#pragma unroll
            for (int s2 = 0; s2 < 2; ++s2) { u32x4 pw; pw.x = cvt_pk_bf16(s[j][8 * s2 + 0], s[j][8 * s2 + 1]); pw.y = cvt_pk_bf16(s[j][8 * s2 + 2], s[j][8 * s2 + 3]);
                pw.z = cvt_pk_bf16(s[j][8 * s2 + 4], s[j][8 * s2 + 5]); pw.w = cvt_pk_bf16(s[j][8 * s2 + 6], s[j][8 * s2 + 7]);
#pragma unroll
                for (int dt = 0; dt < 2; ++dt) { const LAS unsigned char* vp = sb + L_VB + (32 * dt + l31) * VPT + (32 * wq + 32 * j + 16 * s2 + 4 * hh) * 2;
                    const u32x2 lo = *(const LAS u32x2*)vp, hi = *(const LAS u32x2*)(vp + 16); const u32x4 vw = {lo.x, lo.y, hi.x, hi.y};
                    o[dt] = __builtin_amdgcn_mfma_f32_32x32x16_bf16(__builtin_bit_cast(bf16x8, vw), __builtin_bit_cast(bf16x8, pw), o[dt], 0, 0, 0); } } } }
        { LAS unsigned char* ost = lds + L_OST + w * (32 * OPT);
#pragma unroll
          for (int dt = 0; dt < 2; ++dt)
#pragma unroll
              for (int i = 0; i < 4; ++i) { u32x2 wv; wv.x = cvt_pk_bf16(o[dt][4 * i] * inv, o[dt][4 * i + 1] * inv); wv.y = cvt_pk_bf16(o[dt][4 * i + 2] * inv, o[dt][4 * i + 3] * inv);
                  *(LAS u32x2*)(ost + l31 * OPT + (32 * dt + 8 * i + 4 * hh) * 2) = wv; }
          LDS_WAIT();
          bf16_t* obase = AO + (rowb + p0) * D + hq * HD + (lane & 7) * 8;
#pragma unroll
          for (int k = 0; k < 4; ++k) { const int row = (lane >> 3) + 8 * k; const u32x4 v = *(const LAS u32x4*)(ost + row * OPT + (lane & 7) * 16); *(u32x4*)(obase + (size_t)row * D) = v; } }
        if (more) AT_WRITE(buf ^ 1);
        LDS_WAIT(); __syncthreads();
        buf ^= 1;
    }
#undef AT_LOAD
#undef AT_LOADQ
#undef AT_WRITE
}

__device__ __forceinline__ void router_phase(Frame& F, const bf16_t* H3, const u64* rowss, const float* router, const float* gain, gu32* ctl, int* LTOK, float* LG) {
    LAS float* WRG = (LAS float*)F.lds;
    LAS int* SEL = (LAS int*)(F.lds + 32768);
    LAS float* GATE = (LAS float*)(F.lds + 32768 + 1024);
    LAS int* RANK = (LAS int*)(F.lds + 32768 + 3072);
    LAS unsigned* CNT = (LAS unsigned*)(F.lds + 32768 + 5120);
    const int tid = fresh_tid(), lane = tid & 63, w = __builtin_amdgcn_readfirstlane(tid >> 6);
#pragma unroll
    for (int i = 0; i < 4; ++i) { const int q = tid + 512 * i; const f32x4 rv = ((const f32x4*)router)[q]; ((LAS f32x4*)WRG)[q] = rv * gain[q >> 1]; }
    for (int tb = F.vcu; tb < T / 256; tb += F.G) {
        if (tid < 32) CNT[tid] = 0u;
        LDS_WAIT(); __syncthreads();
        unsigned xn[4][8];
#define RT_LOAD(q4_) do { const size_t t0_ = (size_t)tb * 256 + w * 32 + 4 * (q4_); \
            _Pragma("unroll") for (int t = 0; t < 4; ++t) { const unsigned* xr = (const unsigned*)(H3 + (t0_ + t) * D) + lane; _Pragma("unroll") for (int m = 0; m < 8; ++m) xn[t][m] = xr[64 * m]; } } while (0)
        RT_LOAD(0);
#pragma unroll 1
        for (int q4 = 0; q4 < 8; ++q4) {
            const int tl0 = w * 32 + 4 * q4; const size_t tok0 = (size_t)tb * 256 + tl0;
            unsigned xw[4][8];
#pragma unroll
            for (int t = 0; t < 4; ++t)
#pragma unroll
                for (int m = 0; m < 8; ++m) xw[t][m] = xn[t][m];
            if (q4 + 1 < 8) RT_LOAD(q4 + 1);
            float acc[4][8];
#pragma unroll
            for (int t = 0; t < 4; ++t)
#pragma unroll
                for (int e = 0; e < 8; ++e) acc[t][e] = 0.f;
#pragma unroll
            for (int m = 0; m < 8; ++m) { const LAS f32x4* wp = (const LAS f32x4*)(WRG + (2 * lane + 128 * m) * 8); const f32x4 w0 = wp[0], w1 = wp[1], w2 = wp[2], w3 = wp[3];
#pragma unroll
                for (int t = 0; t < 4; ++t) { const float x0 = bf_lo(xw[t][m]), x1 = bf_hi(xw[t][m]);
#pragma unroll
                    for (int e = 0; e < 4; ++e) { fmac_s(acc[t][e], x0, w0[e]); fmac_s(acc[t][e], x1, w2[e]); fmac_s(acc[t][4 + e], x0, w1[e]); fmac_s(acc[t][4 + e], x1, w3[e]); } }
                if (m & 1) asm volatile("" ::: "memory"); }
#pragma unroll
            for (int o = 1; o < 64; o <<= 1) {
#pragma unroll
                for (int t = 0; t < 4; ++t) {
#pragma unroll
                    for (int e = 0; e < 8; ++e) acc[t][e] += __shfl_xor(acc[t][e], o); } }
#pragma unroll
            for (int t = 0; t < 4; ++t) { const int tl = tl0 + t;
                const float r = rinv_of(rowss[tok0 + t]);
                int e1 = 0; float l1 = acc[t][0];
#pragma unroll
                for (int e = 1; e < 8; ++e) if (acc[t][e] > l1) { l1 = acc[t][e]; e1 = e; }
                int e2 = e1 == 0 ? 1 : 0; float l2 = -INFINITY;
#pragma unroll
                for (int e = 0; e < 8; ++e) if (e != e1 && acc[t][e] > l2) { l2 = acc[t][e]; e2 = e; }
                const float g2 = 1.0f / (1.0f + __expf((l1 - l2) * r)), g1 = 1.0f - g2;
                if (lane == 0) { SEL[tl] = e1 | (e2 << 8); GATE[2 * tl] = g1; GATE[2 * tl + 1] = g2; } } }
        LDS_WAIT(); __syncthreads();
        int e1 = 0, e2 = 0;
        if (tid < 256) { const int sv = SEL[tid]; e1 = sv & 255; e2 = sv >> 8; RANK[2 * tid] = (int)__hip_atomic_fetch_add(&CNT[e1], 1u, __ATOMIC_RELAXED, __HIP_MEMORY_SCOPE_WORKGROUP); RANK[2 * tid + 1] = (int)__hip_atomic_fetch_add(&CNT[8 + e2], 1u, __ATOMIC_RELAXED, __HIP_MEMORY_SCOPE_WORKGROUP); }
        LDS_WAIT(); __syncthreads();
        if (tid < 16) CNT[16 + tid] = __hip_atomic_fetch_add(ctl + CW_MCNT + 64 * tid, CNT[tid], RLX_AGENT);
        LDS_WAIT(); __syncthreads();
        if (tid < 256) { const int tok = tb * 256 + tid; const unsigned p1 = CNT[16 + e1] + (unsigned)RANK[2 * tid], p2 = CNT[24 + e2] + (unsigned)RANK[2 * tid + 1];
            LTOK[(size_t)e1 * T + p1] = tok; LG[(size_t)e1 * T + p1] = GATE[2 * tid];
            LTOK[(size_t)(8 + e2) * T + p2] = tok; LG[(size_t)(8 + e2) * T + p2] = GATE[2 * tid + 1]; }
        __syncthreads();
    }
}
__device__ __forceinline__ unsigned moe_counts(const gu32* ctl) {
    const int l = (int)__builtin_amdgcn_mbcnt_hi(~0u, __builtin_amdgcn_mbcnt_lo(~0u, 0u)) & 15;
    return ld_agent((const unsigned*)ctl + CW_MCNT + 64 * l);
}
__device__ __forceinline__ void moe_tiles(const gu32* ctl, int k, int* tstart  , unsigned* cnt = nullptr) {
    const unsigned cv = moe_counts(ctl); int a = 0;
#pragma unroll
    for (int e = 0; e < NE; ++e) { tstart[e] = a; const unsigned c = (unsigned)__builtin_amdgcn_readlane((int)cv, k * 8 + e); if (cnt) cnt[e] = c; a += (int)((c + 255u) >> 8); }
    tstart[NE] = a;
}
__device__ __forceinline__ void rowtable_phase(Frame& F, const gu32* ctl, const int* LTOK, const float* LG, const u64* rowss, int* RTOK, float* RG, float* RRINV, int* TILEE) {
    for (int k = 0; k < 2; ++k) { int ts[9]; unsigned cnt[8]; moe_tiles(ctl, k, ts, cnt);
        const int nrows = ts[NE] * 256;
        for (int pr = F.vcu * 512 + fresh_tid(); pr < nrows; pr += F.G * 512) { const int rt = pr >> 8; int e = 0; int st = 0; unsigned ce = cnt[0];
#pragma unroll
            for (int ee = 1; ee < NE; ++ee) if (rt >= ts[ee]) { e = ee; st = ts[ee]; ce = cnt[ee]; }
            const unsigned pos = (unsigned)(pr - st * 256); int tok = -1; float gt = 0.f, ri = 0.f;
            if (pos < ce) { tok = LTOK[(size_t)(k * 8 + e) * T + pos]; gt = LG[(size_t)(k * 8 + e) * T + pos]; ri = rinv_of(rowss[tok]) * (1.0f / (S8_H3 * S8_WGU)); gt *= 1.0f / (S8_HID * S8_WDN); }
            RTOK[k * MPAD + pr] = tok; RG[k * MPAD + pr] = gt; RRINV[k * MPAD + pr] = ri;
            if ((pr & 255) == 0) TILEE[k * 512 + rt] = e; } }
}

struct Args { Ptrs p; int ph_lo, ph_hi; };
#ifndef DBG_STAGE
#define DBG_STAGE 99
#endif
__global__ void __launch_bounds__(512, 2) fwd_kernel(Args args) {
    extern __shared__ __attribute__((aligned(16))) unsigned char lds_raw[];
    Frame F;
    F.lds = (LAS unsigned char*)lds_raw;
    F.tid = threadIdx.x; F.lane = F.tid & 63; F.wave = __builtin_amdgcn_readfirstlane(F.tid >> 6);
    F.G = gridDim.x; { const int bx = blockIdx.x; F.vcu = (F.G % 8 == 0) ? (bx % 8) * (F.G / 8) + bx / 8 : bx; }
    const Ptrs& P = args.p;
    unsigned char* ws = P.ws;
    gu32* ctl = (gu32*)(ws + WS_CTL);
    volatile LAS unsigned* MISC = (volatile LAS unsigned*)(F.lds + MISC_OFF);
    for (int u = F.tid; u < (LDS_BYTES - PHASE_LDS) / 4; u += 512) ((LAS unsigned*)(F.lds + PHASE_LDS))[u] = 0u;
    __syncthreads();
    XcdBarrier bar = xcd_barrier_post((unsigned*)(ctl + CW_BAR), MISC + 8);
    const int lo = args.ph_lo, hi = args.ph_hi;
#define IN(k) (lo <= (k) && (k) < hi)
#ifndef PROBE_SEAM
#define PROBE_SEAM -1
#endif
    volatile LAS unsigned long long* PRB = (volatile LAS unsigned long long*)(F.lds + MISC_OFF + 64);
    if (PROBE_SEAM >= 0 && fresh_tid() == 0) PRB[0] = __builtin_amdgcn_s_memrealtime();
#define SEAM(k) do { if (IN(k) && IN((k) + 1)) xcd_barrier(bar); if (PROBE_SEAM == (k) && fresh_tid() == 0) PRB[1] = __builtin_amdgcn_s_memrealtime(); } while (0)
    using namespace pg8;
    const int bid = (int)blockIdx.x;
    u64* rowss1 = (u64*)(ws + WS_ROWSS1); u64* rowss2 = (u64*)(ws + WS_ROWSS2); u64* rowss3 = (u64*)(ws + WS_ROWSS3);

    if (IN(0)) { p0_prologue(F, P); } SEAM(0);
    if (IN(1)) { Gemm g{(const bf16_t*)(ws + WS_XN), (const bf16_t*)(ws + WS_WQO), D, 0, nullptr}; StaticOrder S; S.init(T / 256, 4, F.G, bid);
        epi::EpiOG E{(bf16_t*)(ws + WS_OG1)}; gemm_phase<epi::EpiOG, StaticOrder, false>(F.lds, g, S, E, F.wave); }
    if (IN(2)) { Gemm g{(const bf16_t*)(ws + WS_WFI), (const bf16_t*)(ws + WS_XN), D, 0, nullptr}; StaticOrder S; S.init(12, T / 256, F.G, bid);
        static_assert(WS_GT == WS_Q1 + 128 * MiB && WS_VT == WS_GT + 128 * MiB, "QT|GT|VT spacing");
        epi::EpiQFI E{(unsigned short*)(ws + WS_Q1), (const float*)(ws + WS_LB)}; gemm_phase<epi::EpiQFI, StaticOrder, false>(F.lds, g, S, E, F.wave); }
    SEAM(2);
    if (IN(3)) scan_state_pass(F, (const unsigned short*)(ws + WS_GT), (const bf16_t*)(ws + WS_VT), (float*)(ws + WS_SST));
    SEAM(3);
    if (IN(4)) scan_output_pass(F, (const bf16_t*)(ws + WS_Q1), (const unsigned short*)(ws + WS_GT), (const bf16_t*)(ws + WS_VT), (const float*)(ws + WS_SST), (const bf16_t*)(ws + WS_OG1), P.gnorm, (bf16_t*)(ws + WS_OGATED));
    SEAM(4);
    if (IN(5)) { Gemm g{(const bf16_t*)(ws + WS_OGATED), (const bf16_t*)(ws + WS_WOUT), D, 0, nullptr}; StaticOrder S; S.init(T / 256, 4, F.G, bid);
        epi::EpiRes<2, DBG_STAGE == 1> E{(const void*)(ws + WS_XN), (bf16_t*)(ws + WS_H1), P.out, rowss1, nullptr, (const float*)(ws + WS_INVR0), (const float*)(ws + WS_INVG)}; gemm_phase<epi::EpiRes<2, DBG_STAGE == 1>, StaticOrder, false>(F.lds, g, S, E, F.wave); }
    SEAM(5);
#if DBG_STAGE >= 2
    if (IN(6)) { Gemm g{(const bf16_t*)(ws + WS_H1), (const bf16_t*)(ws + WS_WGU), D, 0, nullptr}; StaticOrder S; S.init(T / 256, 2 * FF0 / 256, F.G, bid);
        epi::EpiGU<false> E{(bf16_t*)(ws + WS_HID0), FF0, rowss1}; gemm_phase<epi::EpiGU<false>, StaticOrder, false>(F.lds, g, S, E, F.wave); }
    SEAM(6);
    if (IN(7)) { Gemm g{(const bf16_t*)(ws + WS_HID0), (const bf16_t*)(ws + WS_WDN), FF0, 0, nullptr}; StaticOrder S; S.init(T / 256, 4, F.G, bid);
        epi::EpiRes<0, DBG_STAGE == 2> E{(const void*)(ws + WS_H1), (bf16_t*)(ws + WS_H2), P.out, rowss2, nullptr, nullptr, nullptr}; gemm_phase<epi::EpiRes<0, DBG_STAGE == 2>, StaticOrder, false>(F.lds, g, S, E, F.wave); }
    SEAM(7);
#endif
#if DBG_STAGE >= 3
    if (IN(8)) { { Gemm g{(const bf16_t*)(ws + WS_H2), (const bf16_t*)(ws + WS_WQK), D, 0, nullptr}; StaticOrder S; S.init(T / 256, 5, F.G, bid);
          epi::EpiQK E{(bf16_t*)(ws + WS_Q2), (bf16_t*)(ws + WS_K2), rowss2, P.q_gain, P.k_gain}; gemm_phase<epi::EpiQK, StaticOrder, false>(F.lds, g, S, E, F.wave); }
        { Gemm g{(const bf16_t*)(ws + WS_WV), (const bf16_t*)(ws + WS_H2), D, 0, nullptr}; StaticOrder S; S.init(1, T / 256, F.G, bid);
          epi::EpiVT E{(bf16_t*)(ws + WS_VT2), rowss2}; gemm_phase<epi::EpiVT, StaticOrder, false>(F.lds, g, S, E, F.wave); } }
    SEAM(8);
    if (IN(9)) attn_phase(F, (const bf16_t*)(ws + WS_Q2), (const bf16_t*)(ws + WS_K2), (const bf16_t*)(ws + WS_VT2), P.rel_bias, P.sink, (bf16_t*)(ws + WS_AO));
    SEAM(9);
    if (IN(10)) { Gemm g{(const bf16_t*)(ws + WS_AO), (const bf16_t*)(ws + WS_WO), D, 0, nullptr}; StaticOrder S; S.init(T / 256, 4, F.G, bid);
        epi::EpiRes<0, false, true> E{(const void*)(ws + WS_H2), (bf16_t*)(ws + WS_H2), nullptr, rowss3, ws + WS_H38, nullptr, nullptr}; gemm_phase<epi::EpiRes<0, false, true>, StaticOrder, false>(F.lds, g, S, E, F.wave); }
    SEAM(10);
#endif
#if DBG_STAGE >= 4
    if (IN(11)) router_phase(F, (const bf16_t*)(ws + WS_H2), rowss3, P.router, P.ffn_norm + D, ctl, (int*)(ws + WS_LTOK), (float*)(ws + WS_LG));
    SEAM(11);
    if (IN(12)) rowtable_phase(F, ctl, (const int*)(ws + WS_LTOK), (const float*)(ws + WS_LG), rowss3, (int*)(ws + WS_RTOK), (float*)(ws + WS_RG), (float*)(ws + WS_RRINV), (int*)(ws + WS_TILEE));
    SEAM(12);
#pragma unroll
    for (int k = 0; k < 2; ++k) {
        if (IN(13 + 2 * k)) { int ts[9]; moe_tiles(ctl, k, ts);
            Gemm g{(const bf16_t*)(ws + WS_H38), (const bf16_t*)(ws + WS_MGU), D, (size_t)2 * FFE * D, (const int*)(ws + WS_RTOK) + k * MPAD};   StaticOrder S; S.init(ts[NE], 2 * FFE / 256, F.G, k == 0 ? bid : F.G - 1 - bid  , ts);
            epi::EpiGU<true> E{(bf16_t*)(ws + WS_HIDM + (size_t)k * MPAD * FFE), FFE, (const float*)(ws + WS_RRINV) + k * MPAD}; gemm_phase<epi::EpiGU<true>, StaticOrder, true, true>(F.lds, g, S, E, F.wave); }
        SEAM(13 + 2 * k);
        if (IN(14 + 2 * k)) { int ts[9]; moe_tiles(ctl, k, ts);
            Gemm g{(const bf16_t*)(ws + WS_HIDM + (size_t)k * MPAD * FFE), (const bf16_t*)(ws + WS_MDN), FFE, (size_t)D * FFE, nullptr}; StaticOrder S; S.init(ts[NE], 4, F.G, bid, ts);
            if (k == 0) { epi::EpiMoeDown<true> E{P.out, (const int*)(ws + WS_RTOK), (const float*)(ws + WS_RG), (bf16_t*)(ws + WS_H2), ws + WS_TILEE + 65536}; gemm_phase<epi::EpiMoeDown<true>, StaticOrder, false, true>(F.lds, g, S, E, F.wave); }
            else { epi::EpiMoeDown<false> E{P.out, (const int*)(ws + WS_RTOK) + MPAD, (const float*)(ws + WS_RG) + MPAD, (bf16_t*)(ws + WS_H2), ws + WS_TILEE + 65536}; gemm_phase<epi::EpiMoeDown<false>, StaticOrder, false, true>(F.lds, g, S, E, F.wave); } }
        if (k == 1) SEAM(14 + 2 * k);
    }
#endif
    if (PROBE_SEAM >= 0 && blockIdx.x == 0 && fresh_tid() == 0) { const unsigned long long tend = __builtin_amdgcn_s_memrealtime(), want = 8ull * (PRB[1] - PRB[0]);
        while (__builtin_amdgcn_s_memrealtime() - tend < want) __builtin_amdgcn_s_sleep(32); }
#undef IN
#undef SEAM
}
constexpr int N_PHASES = 17;

extern "C" void kernel_launch(void* const* d_in, const int* in_sizes, int n_in, void* d_out, int out_size, void* d_ws, size_t ws_size, hipStream_t stream) {
    static int grid = 0;
    if (grid == 0) {
        if (n_in != 22 || in_sizes[0] != T * D || out_size != T * D || ws_size < WS_END) { fprintf(stderr, "kernel_launch: unexpected shapes/workspace: n_in %d in0 %d out %d ws %zu (need %zu)\n", n_in, n_in > 0 ? in_sizes[0] : -1, out_size, ws_size, (size_t)WS_END); grid = -1; return; }
        int dev = 0, cus = 0, per_cu = 0;
        if (hipGetDevice(&dev) != hipSuccess || hipDeviceGetAttribute(&cus, hipDeviceAttributeMultiprocessorCount, dev) != hipSuccess) { fprintf(stderr, "kernel_launch: device query failed\n"); grid = -1; return; }
        if (hipFuncSetAttribute((const void*)fwd_kernel, hipFuncAttributeMaxDynamicSharedMemorySize, LDS_BYTES) != hipSuccess) { fprintf(stderr, "kernel_launch: hipFuncSetAttribute failed\n"); grid = -1; return; }
        if (hipOccupancyMaxActiveBlocksPerMultiprocessor(&per_cu, (const void*)fwd_kernel, 512, LDS_BYTES) != hipSuccess || per_cu < 1) fprintf(stderr, "kernel_launch: occupancy query reports %d blocks per CU\n", per_cu);
        (void)hipGetLastError();
        grid = cus;
    }
    if (grid < 0) return;
    if (hipMemsetAsync((char*)d_ws + WS_CTL, 0, CTL_ZERO_BYTES, stream) != hipSuccess) { fprintf(stderr, "kernel_launch: memset failed\n"); return; }
    Args a{};
    const float** pp = (const float**)&a.p;
    for (int i = 0; i < 22; ++i) pp[i] = (const float*)d_in[i];
    a.p.out = (float*)d_out; a.p.ws = (unsigned char*)d_ws;
    a.ph_lo = 0; a.ph_hi = N_PHASES;
    hipLaunchKernelGGL(fwd_kernel, dim3(grid), dim3(512), LDS_BYTES, stream, a);
    const hipError_t le = hipPeekAtLastError();
    if (le != hipSuccess) fprintf(stderr, "kernel_launch: launch failed: %s\n", hipGetErrorName(le));
}
```

```cpp
#include <hip/hip_runtime.h>
#include <cstdio>
#include <cstdint>

#define LAS __attribute__((address_space(3)))
#define GAS __attribute__((address_space(1)))
typedef unsigned short bf16_t;
typedef short bf16x8 __attribute__((ext_vector_type(8)));
typedef short s16x4 __attribute__((ext_vector_type(4)));
typedef float f32x4 __attribute__((ext_vector_type(4)));
typedef float f32x2 __attribute__((ext_vector_type(2)));
typedef float f32x16 __attribute__((ext_vector_type(16)));
typedef unsigned u32x4 __attribute__((ext_vector_type(4)));
typedef unsigned u32x2 __attribute__((ext_vector_type(2)));
typedef _Float16 f16x2 __attribute__((ext_vector_type(2)));
typedef GAS unsigned gu32;
typedef int i32x4 __attribute__((ext_vector_type(4)));
typedef int i32x8 __attribute__((ext_vector_type(8)));

constexpr int BATCH = 8, SEQ = 8192, D = 1024, T = BATCH * SEQ;
constexpr int HG_H = 8, HG_DK = 128, CHK = 64, NCHK = SEQ / CHK;
constexpr int FF0 = 2816, NE = 8, FFE = 3584;
constexpr int QH = 16, KVH = 4, HD = 64, WIN = 128;
constexpr float EPS = 1e-6f;
constexpr float LOG2E = 1.4426950408889634f;
constexpr float S8_H3 = 8.0f, S8_WGU = 64.0f, S8_HID = 8.0f, S8_WDN = 128.0f;
constexpr int MPAD = T + NE * 256;
constexpr int MAXRT = MPAD / 256;

constexpr size_t MiB = 1u << 20;
constexpr size_t WS_CTL = 0, CTL_ZERO_BYTES = 4 * MiB;
constexpr size_t WS_ROWSS1 = 1 * MiB, WS_ROWSS2 = WS_ROWSS1 + 512 * 1024, WS_ROWSS3 = WS_ROWSS2 + 512 * 1024;
constexpr size_t WS_LB = 4 * MiB;
constexpr size_t WS_INVG = 4 * MiB + 8192, WS_INVR0 = 4 * MiB + 65536;
constexpr size_t WS_DCH = 5 * MiB;
constexpr size_t WS_LTOK = 9 * MiB, WS_LG = 13 * MiB;
constexpr size_t WS_RTOK = 17 * MiB, WS_RG = 18 * MiB, WS_RRINV = 19 * MiB, WS_TILEE = 20 * MiB;
constexpr size_t WS_WQO = 24 * MiB  , WS_WFI = 26 * MiB  , WS_WOUT = 32 * MiB, WS_WGU = 34 * MiB, WS_WDN = 45 * MiB, WS_WQK = 51 * MiB, WS_WV = 54 * MiB, WS_WO = 55 * MiB;
constexpr size_t WS_MGU = 57 * MiB, WS_MDN = 169 * MiB;
constexpr size_t WS_R0 = 226 * MiB, WS_R1 = 354 * MiB, WS_R2 = 482 * MiB, WS_R3 = 866 * MiB, WS_END = 994 * MiB;
constexpr size_t WS_XN = WS_R0, WS_H2 = WS_R0;
constexpr size_t WS_Q1 = WS_R1, WS_H1 = WS_R1, WS_AO = WS_R1, WS_HIDM = WS_R1;
constexpr size_t WS_GT = WS_R2, WS_VT = WS_R2 + 128 * MiB, WS_OG1 = WS_R2 + 256 * MiB, WS_HID0 = WS_R2;
constexpr size_t WS_OGATED = WS_OG1;
constexpr size_t WS_Q2 = WS_R2, WS_K2 = WS_R2 + 128 * MiB, WS_VT2 = WS_R2 + 160 * MiB;
constexpr size_t WS_H38 = WS_R3;
constexpr size_t WS_SST = WS_R3;
static_assert(WS_HIDM + (size_t)2 * MPAD * FFE <= WS_R3, "two fp8 hid buffers fit below H38");
static_assert(WS_HID0 + (size_t)T * FF0 * 2 <= WS_R3, "HID0 fits");
constexpr int CW_BAR = 4096;
constexpr int CW_MCNT = 16384;

constexpr int RING_BYTES = 131072;
constexpr int LDS_BYTES = 163840;
constexpr int PHASE_LDS = LDS_BYTES - 1024;
constexpr int MISC_OFF = PHASE_LDS + 320;

#define LDS_WAIT() asm volatile("s_waitcnt lgkmcnt(0)" ::: "memory")
#define VM_WAIT() asm volatile("s_waitcnt vmcnt(0)" ::: "memory")
#define RLX_AGENT __ATOMIC_RELAXED, __HIP_MEMORY_SCOPE_AGENT

__device__ __forceinline__ unsigned f2bf(float f) { unsigned u = __builtin_bit_cast(unsigned, f); return (u + 0x7fffu + ((u >> 16) & 1u)) >> 16; }
__device__ __forceinline__ unsigned pk2(float lo, float hi) { return f2bf(lo) | (f2bf(hi) << 16); }
__device__ __forceinline__ unsigned cvt_pk_bf16(float lo, float hi) { unsigned r; asm volatile("v_cvt_pk_bf16_f32 %0, %1, %2" : "=v"(r) : "v"(lo), "v"(hi)); return r; }
__device__ __forceinline__ float bf_lo(unsigned w) { return __builtin_bit_cast(float, w << 16); }
__device__ __forceinline__ float bf_hi(unsigned w) { return __builtin_bit_cast(float, w & 0xffff0000u); }
__device__ __forceinline__ float bf1(bf16_t h) { return __builtin_bit_cast(float, (unsigned)h << 16); }
__device__ __forceinline__ unsigned pk_f16(float lo, float hi) { f16x2 v = {(_Float16)lo, (_Float16)hi}; return __builtin_bit_cast(unsigned, v); }
__device__ __forceinline__ unsigned pk4_fp8(float a, float b, float c, float d) { unsigned r = 0u; r = (unsigned)__builtin_amdgcn_cvt_pk_fp8_f32(a, b, (int)r, false); r = (unsigned)__builtin_amdgcn_cvt_pk_fp8_f32(c, d, (int)r, true); return r; }
__device__ __forceinline__ float clamp8(float v) { return __builtin_amdgcn_fmed3f(v, -440.0f, 440.0f); }
__device__ __forceinline__ float fast_exp(float x) { return __builtin_amdgcn_exp2f(x * LOG2E); }
__device__ __forceinline__ void fmac_s(float& acc, float a, float b) { asm("v_fmac_f32_e32 %0, %1, %2" : "+v"(acc) : "v"(a), "v"(b)); }
__device__ __forceinline__ float fast_rcp(float x) { return __builtin_amdgcn_rcpf(x); }
__device__ __forceinline__ float silu_f(float v) { return v * fast_rcp(1.0f + fast_exp(-v)); }
__device__ __forceinline__ int fresh_tid_w(int wave) { int t = wave * 64 + (int)__builtin_amdgcn_mbcnt_hi(~0u, __builtin_amdgcn_mbcnt_lo(~0u, 0u)); asm volatile("" : "+v"(t)); return t; }
#define fresh_tid() fresh_tid_w(F.wave)
__device__ __forceinline__ unsigned ld_agent(const unsigned* p) { return __hip_atomic_load((unsigned*)p, RLX_AGENT); }
typedef unsigned long long u64;
constexpr float SS_FIX = 1048576.0f;
__device__ __forceinline__ float rinv_of(u64 ssfix) { return __builtin_amdgcn_rsqf((float)ssfix * (1.0f / (SS_FIX * D)) + EPS); }

namespace pg8 {
constexpr int BM = 256, BK = 64, HALF = 128, HTB = HALF * BK * 2, STAGE_BYTES = 8 * HTB, NXCD = 8, WGM = 8;
__host__ __device__ __forceinline__ int lds_byte(int r, int c) { const int st = (r >> 4) * 2 + (c >> 5), rr = r & 15, cc = c & 31, ob = rr * 64 + cc * 2; return st * 1024 + (ob ^ (((ob >> 9) & 1) << 5)); }
__host__ __device__ __forceinline__ void stage_rc(int b, int& R, int& C) { const int st = b / 1024, sb = b % 1024, swz = sb ^ (((sb >> 9) & 1) << 5); R = (st >> 1) * 16 + swz / 64; C = (st & 1) * 32 + (swz % 64) / 2; }
__host__ __device__ __forceinline__ int perm32(int rho) { const int n = rho >> 4, i = rho & 15; return 8 * (i >> 2) + 4 * n + (i & 3); }

struct Unit { int pm, pn, e; };
struct Gemm { const bf16_t* A; const bf16_t* Bt; int K; size_t bstride  ; const int* rowtok  ; };

struct StaticOrder {
    int nM, nN, nwg, G, c; bool tiled; int ts[8];
    __device__ void init(int nM_, int nN_, int G_, int c_, const int* tstart = nullptr) { nM = nM_; nN = nN_; nwg = nM * nN; G = G_; c = c_; tiled = tstart != nullptr;
#pragma unroll
        for (int e = 0; e < 8; ++e) ts[e] = tstart ? tstart[e] : 0; }
    __device__ bool next(int i, Unit& u) const {
        const long L = (long)i * G + c; if (L >= nwg) return false;
        int wgid = (int)L; { const int q = nwg / NXCD, r = nwg % NXCD, xcd = wgid % NXCD, off = wgid / NXCD; wgid = (xcd < r ? xcd * (q + 1) : r * (q + 1) + (xcd - r) * q) + off; }
        const int nig = WGM * nN, gid = wgid / nig, fm = gid * WGM, gsz = (nM - fm) < WGM ? (nM - fm) : WGM;
        u.pm = fm + ((wgid % nig) % gsz); u.pn = (wgid % nig) / gsz;
        int e_ = 0;
        if (tiled) {
#pragma unroll
            for (int e = 1; e < 8; ++e) e_ += (u.pm >= ts[e]) ? 1 : 0; }
        u.e = e_;
        return true;
    }
};

template <class Epi, class Sched, bool GATHER, bool FP8 = false>
__device__ __forceinline__ void gemm_phase(LAS unsigned char* lds, const Gemm g, const Sched& S, const Epi& E, int wave_sgpr) {
    const int tid = fresh_tid_w(wave_sgpr), wid = __builtin_amdgcn_readfirstlane(tid >> 6), lane = tid & 63, wr = wid >> 2, wc = wid & 3, fr = lane & 15, fq = lane >> 4;
    const int K = g.K, RB = FP8 ? K : 2 * K  , nt = RB / (BK * 2);
    unsigned voffA[2], voffB[2]; int RA[2], CA[2];
#pragma unroll
    for (int i = 0; i < 2; ++i) { int R, C; stage_rc(tid * 16 + i * 8192, R, C); const int Rb = (R & ~31) + perm32(R & 31);
        RA[i] = R; CA[i] = C; voffA[i] = (unsigned)(R * RB + C * 2); voffB[i] = (unsigned)(Rb * RB + C * 2); }
    const size_t kstep = (size_t)(BK * 2);
    const size_t hstep = (size_t)HALF * RB;
    const size_t tstep = 2 * hstep;
    const unsigned ldsw = (unsigned)wid * 1024u;
    const int aoff = lds_byte(wr * 64 + fr, fq * 8), boff = lds_byte(wc * 32 + fr, fq * 8);
#define PG8_SA(b, h) (((b) * 2 + (h)) * HTB)
#define PG8_SB(b, h) ((4 + (b) * 2 + (h)) * HTB)
#define PG8_STAGE(bufoff, gbase, voff) do { _Pragma("unroll") for (int _i = 0; _i < 2; ++_i) \
        __builtin_amdgcn_global_load_lds((const unsigned*)((const char*)(gbase) + (voff)[_i]), (LAS unsigned*)(lds + (bufoff) + ldsw + _i * 8192), 16, 0, 0); } while (0)
#define PG8_STAGE_B(b, h, q) do { const bool w_ = (q) >= nt; const char* gb_ = (w_ ? nB : cB) + (size_t)(h) * hstep + (size_t)(w_ ? (q) - nt : (q)) * kstep; PG8_STAGE(PG8_SB(b, h), gb_, voffB); } while (0)
#define PG8_STAGE_A(b, h, q) do { const bool w_ = (q) >= nt; \
        if constexpr (GATHER) { const char* gb_ = (const char*)g.A + (size_t)(w_ ? (q) - nt : (q)) * kstep; unsigned go_[2]; go_[0] = w_ ? goffn[h][0] : goff[h][0]; go_[1] = w_ ? goffn[h][1] : goff[h][1]; PG8_STAGE(PG8_SA(b, h), gb_, go_); } \
        else { const char* gb_ = (w_ ? nA : cA) + (size_t)(h) * hstep + (size_t)(w_ ? (q) - nt : (q)) * kstep; PG8_STAGE(PG8_SA(b, h), gb_, voffA); } } while (0)
#define PG8_LDA(dst, b, h) do { _Pragma("unroll") for (int m = 0; m < 4; ++m) _Pragma("unroll") for (int k = 0; k < 2; ++k) dst[m][k] = *(const LAS bf16x8*)(lds + PG8_SA(b, h) + aoff + m * 2048 + k * 1024); } while (0)
#define PG8_LDB(dst, b, h) do { _Pragma("unroll") for (int n = 0; n < 2; ++n) _Pragma("unroll") for (int k = 0; k < 2; ++k) dst[n][k] = *(const LAS bf16x8*)(lds + PG8_SB(b, h) + boff + n * 2048 + k * 1024); } while (0)
#define PG8_MMA(ai, bj, At, Bt) do { __builtin_amdgcn_s_setprio(1); \
        if constexpr (FP8) { _Pragma("unroll") for (int m = 0; m < 4; ++m) _Pragma("unroll") for (int n = 0; n < 2; ++n) { \
            const i32x8 a8_ = __builtin_shufflevector(__builtin_bit_cast(i32x4, At[m][0]), __builtin_bit_cast(i32x4, At[m][1]), 0, 1, 2, 3, 4, 5, 6, 7); \
            const i32x8 b8_ = __builtin_shufflevector(__builtin_bit_cast(i32x4, Bt[n][0]), __builtin_bit_cast(i32x4, Bt[n][1]), 0, 1, 2, 3, 4, 5, 6, 7); \
            asm volatile("v_mfma_scale_f32_16x16x128_f8f6f4 %0, %1, %2, %0, %3, %3 op_sel_hi:[0,0,0]" : "+v"(acc[ai][bj][m][n]) : "v"(b8_), "v"(a8_), "v"(sc8_)); } } \
        else { _Pragma("unroll") for (int m = 0; m < 4; ++m) _Pragma("unroll") for (int n = 0; n < 2; ++n) _Pragma("unroll") for (int k = 0; k < 2; ++k) \
            acc[ai][bj][m][n] = __builtin_amdgcn_mfma_f32_16x16x32_bf16(Bt[n][k], At[m][k], acc[ai][bj][m][n], 0, 0, 0); } \
        __builtin_amdgcn_s_setprio(0); } while (0)
#define PG8_WAIT_V(n) asm volatile("s_waitcnt vmcnt(" #n ")" ::: "memory")
#define PG8_WAIT_L(n) asm volatile("s_waitcnt lgkmcnt(" #n ")" ::: "memory")
#define PG8_BAR __builtin_amdgcn_s_barrier()
#define PG8_SCHED __builtin_amdgcn_sched_barrier(0)
#define PG8_GOFF(dst, u) do { _Pragma("unroll") for (int h_ = 0; h_ < 2; ++h_) _Pragma("unroll") for (int i_ = 0; i_ < 2; ++i_) { \
        const int tk_ = g.rowtok[(u).pm * BM + h_ * HALF + RA[i_]]; dst[h_][i_] = (unsigned)((tk_ < 0 ? 0 : tk_) * RB + CA[i_] * 2); } } while (0)
    Unit cur, nxt; int ui = 0;
    if (!S.next(0, cur)) return;
    f32x4 acc[2][2][4][2];
#pragma unroll
    for (int a = 0; a < 2; ++a)
#pragma unroll
        for (int b = 0; b < 2; ++b)
#pragma unroll
            for (int m = 0; m < 4; ++m)
#pragma unroll
                for (int n = 0; n < 2; ++n) acc[a][b][m][n] = (f32x4){0.f, 0.f, 0.f, 0.f};
    bf16x8 At[4][2], B0[2][2], B1[2][2];
    const int sc8_ = 0x7f7f7f7f;
    unsigned goff[2][2], goffn[2][2];
    if constexpr (GATHER) { PG8_GOFF(goff, cur); } else { goff[0][0] = goff[0][1] = goff[1][0] = goff[1][1] = 0u; }
#pragma unroll
    for (int h_ = 0; h_ < 2; ++h_) { goffn[h_][0] = goff[h_][0]; goffn[h_][1] = goff[h_][1]; }
    const char* cA = (const char*)g.A + (GATHER ? (size_t)0 : (size_t)cur.pm * tstep);
    const char* cB = (const char*)g.Bt + ((size_t)cur.e * g.bstride) * (FP8 ? 1 : 2) + (size_t)cur.pn * tstep;
    const char* nA = cA; const char* nB = cB;
#define PG8_PRE(unit_, slot_) do { if constexpr (Epi::PRE != 0) { if (wid < Epi::PRE) \
        __builtin_amdgcn_global_load_lds((const unsigned*)((const char*)E.pre_src(unit_) + (wid * 64 + lane) * 4), (LAS unsigned*)(lds + RING_BYTES + 1024 + (slot_) * 2048 + wid * 256), 4, 0, 0); } } while (0)
    PG8_PRE(cur, 0);
    PG8_STAGE_B(0, 0, 0); PG8_STAGE_B(0, 1, 0); PG8_STAGE_A(0, 0, 0); PG8_STAGE_A(0, 1, 0);
    if (wr == 1) PG8_BAR;
    PG8_WAIT_V(2); PG8_BAR;
    PG8_STAGE_B(1, 0, 1); PG8_STAGE_A(1, 0, 1); PG8_STAGE_B(1, 1, 1);
    PG8_WAIT_V(6); PG8_BAR;
    for (;;) {
        const bool has_next = S.next(ui + 1, nxt);
        if (!has_next) nxt = cur;
        nA = (const char*)g.A + (GATHER ? (size_t)0 : (size_t)nxt.pm * tstep);
        nB = (const char*)g.Bt + ((size_t)nxt.e * g.bstride) * (FP8 ? 1 : 2) + (size_t)nxt.pn * tstep;
        if (has_next) { PG8_PRE(nxt, (ui + 1) % 3);
            if constexpr (GATHER) { if (wid < 4) __builtin_amdgcn_global_load_lds((const unsigned*)(g.rowtok + nxt.pm * BM + wid * 64 + lane), (LAS unsigned*)(lds + RING_BYTES + wid * 256), 4, 0, 0); } }
        for (int t = 0; t < nt; t += 2) {
            if constexpr (GATHER) { if (t == nt - 2 && has_next) {
#pragma unroll
                for (int h_ = 0; h_ < 2; ++h_)
#pragma unroll
                    for (int i_ = 0; i_ < 2; ++i_) { const int tk_ = *(const LAS int*)(lds + RING_BYTES + (h_ * HALF + RA[i_]) * 4); goffn[h_][i_] = (unsigned)((tk_ < 0 ? 0 : tk_) * RB + CA[i_] * 2); } } }
            PG8_LDB(B0, 0, 0); PG8_LDB(B1, 0, 1); PG8_SCHED; PG8_LDA(At, 0, 0); PG8_STAGE_A(1, 1, t + 1);
            PG8_WAIT_V(8); PG8_WAIT_L(0); PG8_BAR; PG8_MMA(0, 0, At, B0); PG8_MMA(0, 1, At, B1); PG8_BAR; PG8_SCHED;
            PG8_LDA(At, 0, 1); PG8_STAGE_B(0, 0, t + 2); PG8_STAGE_B(0, 1, t + 2); PG8_STAGE_A(0, 0, t + 2);
            PG8_WAIT_V(8); PG8_WAIT_L(0); PG8_BAR; PG8_MMA(1, 0, At, B0); PG8_MMA(1, 1, At, B1); PG8_BAR; PG8_SCHED;
            PG8_LDB(B0, 1, 0); PG8_LDB(B1, 1, 1); PG8_SCHED; PG8_LDA(At, 1, 0); PG8_STAGE_A(0, 1, t + 2);
            PG8_WAIT_V(8); PG8_WAIT_L(0); PG8_BAR; PG8_MMA(0, 0, At, B0); PG8_MMA(0, 1, At, B1); PG8_BAR; PG8_SCHED;
            PG8_LDA(At, 1, 1); PG8_STAGE_B(1, 0, t + 3); PG8_STAGE_B(1, 1, t + 3); PG8_STAGE_A(1, 0, t + 3);
            PG8_WAIT_V(8); PG8_WAIT_L(0); PG8_BAR; PG8_MMA(1, 0, At, B0); PG8_MMA(1, 1, At, B1); PG8_BAR; PG8_SCHED;
        }
        if (wr == 0) PG8_BAR;
        if constexpr (FP8) asm volatile("s_nop 15\n\ts_nop 7" ::: "memory");
        E(acc, cur, wr, wc, fr, fq, lds + RING_BYTES + 1024 + (ui % 3) * 2048);
        if (!has_next) break;
#pragma unroll
        for (int a = 0; a < 2; ++a)
#pragma unroll
            for (int b = 0; b < 2; ++b)
#pragma unroll
                for (int m = 0; m < 4; ++m)
#pragma unroll
                    for (int n = 0; n < 2; ++n) acc[a][b][m][n] = (f32x4){0.f, 0.f, 0.f, 0.f};
        cur = nxt; cA = nA; cB = nB; ++ui;
#pragma unroll
        for (int h_ = 0; h_ < 2; ++h_) { goff[h_][0] = goffn[h_][0]; goff[h_][1] = goffn[h_][1]; }
        if (wr == 1) PG8_BAR;
    }
    PG8_WAIT_V(0);
    PG8_BAR;
#undef PG8_SA
#undef PG8_SB
#undef PG8_STAGE
#undef PG8_STAGE_A
#undef PG8_STAGE_B
#undef PG8_LDA
#undef PG8_LDB
#undef PG8_MMA
#undef PG8_WAIT_V
#undef PG8_WAIT_L
#undef PG8_BAR
#undef PG8_SCHED
#undef PG8_GOFF
#undef PG8_PRE
}
}

#define XB_TMO      128
#define XB_XCNT(j)  (256  + 64 * (j))
#define XB_XSUB(j)  (1280 + 64 * (j))
#define XB_XGEN(j)  (2304 + 64 * (j))
#define XB_TOP      3328
#define XB_TOPGEN   3392
#define XCD_BAR_WORDS 3456
#define XB_SPIN_CAP (1u << 18)
__device__ __forceinline__ unsigned xb_ld(unsigned* p)              { return __hip_atomic_load(p, __ATOMIC_RELAXED, __HIP_MEMORY_SCOPE_AGENT); }
__device__ __forceinline__ unsigned xb_add(unsigned* p, unsigned v) { return __hip_atomic_fetch_add(p, v, __ATOMIC_RELAXED, __HIP_MEMORY_SCOPE_AGENT); }
__device__ __forceinline__ unsigned xb_xcc_id() { return (unsigned)__builtin_amdgcn_s_getreg((3 << 11) | 20) & 0xFu; }
#define XB_SPIN(cond, bar) do { unsigned _sp = 0; while (cond) { __builtin_amdgcn_s_sleep(1); \
    if ((++_sp & 255u) == 0u) { if (xb_ld(&(bar)[XB_TMO])) break; if (_sp > XB_SPIN_CAP) { atomicAdd(&(bar)[XB_TMO], 1u); break; } } } } while (0)
struct XcdBarrier { unsigned* bar; unsigned x; volatile LAS unsigned* st; };
__device__ __forceinline__ XcdBarrier xcd_barrier_post(unsigned* bar, volatile LAS unsigned* st) {
    XcdBarrier b; b.bar = bar; b.x = xb_xcc_id(); b.st = st;
    if (threadIdx.x == 0) (void)xb_add(&bar[XB_XCNT(b.x)], 1u);
    return b;
}
__device__ __forceinline__ void xcd_barrier_complete(unsigned* bar, unsigned x, unsigned& nloc, unsigned& nx) {
    const unsigned G = gridDim.x * gridDim.y * gridDim.z;
    unsigned sum, cnt, mine, sp = 0u;
    for (;;) {
        sum = 0u; cnt = 0u; mine = 0u;
#pragma unroll
        for (unsigned j = 0; j < 16; ++j) { const unsigned c = xb_ld(&bar[XB_XCNT(j)]); sum += c; cnt += (c > 0u) ? 1u : 0u; mine = (j == x) ? c : mine; }
        if (sum == G) break;
        __builtin_amdgcn_s_sleep(1);
        if ((++sp & 255u) == 0u) { if (xb_ld(&bar[XB_TMO])) break; if (sp > XB_SPIN_CAP) { atomicAdd(&bar[XB_TMO], 1u); break; } }
    }
    nloc = mine > 0u ? mine : 1u; nx = cnt > 0u ? cnt : 1u;
}
__device__ __forceinline__ void xcd_barrier(const XcdBarrier& b) {
    asm volatile("s_waitcnt vmcnt(0)" ::: "memory");
    __syncthreads();
    if (threadIdx.x == 0) {
        unsigned* bar = b.bar;
        __builtin_amdgcn_s_waitcnt(0);
        unsigned nloc = b.st[0], nx = b.st[1];
        if (nloc == 0u) { xcd_barrier_complete(bar, b.x, nloc, nx); b.st[0] = nloc; b.st[1] = nx; }
        const unsigned old = xb_add(&bar[XB_XSUB(b.x)], 1u);
        const unsigned gen = old / nloc;
        if (old + 1u == (gen + 1u) * nloc) {
            __builtin_amdgcn_fence(__ATOMIC_RELEASE, "agent");
            asm volatile("s_waitcnt vmcnt(0)" ::: "memory");
            const unsigned og = xb_add(&bar[XB_TOP], 1u);
            const unsigned tg = og / nx;
            if (og + 1u == (tg + 1u) * nx) xb_add(&bar[XB_TOPGEN], 1u);
            else XB_SPIN(xb_ld(&bar[XB_TOPGEN]) == tg, bar);
            __builtin_amdgcn_fence(__ATOMIC_ACQUIRE, "agent");
            xb_add(&bar[XB_XGEN(b.x)], 1u);
            asm volatile("s_waitcnt vmcnt(0)" ::: "memory");
        } else {
            XB_SPIN(xb_ld(&bar[XB_XGEN(b.x)]) == gen, bar);
            __builtin_amdgcn_fence(__ATOMIC_ACQUIRE, "agent");
            asm volatile("s_waitcnt vmcnt(0)" ::: "memory");
        }
    }
    __syncthreads();
}

struct Frame {
    LAS unsigned char* lds;
    int tid, lane, wave, vcu, G;
};
__device__ __forceinline__ float wave_sum(float v) {
#pragma unroll
    for (int o = 1; o < 64; o <<= 1) v += __shfl_xor(v, o);
    return v;
}
__device__ __forceinline__ void transpose_item(const float* W, int K, int N, int k0, int nsrc0, bf16_t* WT, int drow0, const float* gain, LAS float* scr, int lane) {
    f32x4 ld[8];
#pragma unroll
    for (int i = 0; i < 8; ++i) ld[i] = *(const f32x4*)(W + (size_t)(k0 + 8 * i + (lane >> 3)) * N + nsrc0 + 4 * (lane & 7));
#pragma unroll
    for (int i = 0; i < 8; ++i) { const int kk = 8 * i + (lane >> 3); f32x4 v = ld[i]; if (gain) v *= gain[k0 + kk]; LAS float* d = scr + kk * 33 + 4 * (lane & 7); d[0] = v[0]; d[1] = v[1]; d[2] = v[2]; d[3] = v[3]; }
    LDS_WAIT(); asm volatile("" ::: "memory");
    const int c = lane & 7;
#pragma unroll
    for (int j = 0; j < 4; ++j) { const int n = (lane >> 3) + 8 * j; const LAS float* s = scr + (8 * c) * 33 + n;
        u32x4 o; o.x = pk2(s[0 * 33], s[1 * 33]); o.y = pk2(s[2 * 33], s[3 * 33]); o.z = pk2(s[4 * 33], s[5 * 33]); o.w = pk2(s[6 * 33], s[7 * 33]);
        *(GAS u32x4*)(WT + (size_t)(drow0 + n) * K + k0 + 8 * c) = o; }
    LDS_WAIT(); asm volatile("" ::: "memory");
}
__device__ __forceinline__ void transpose_item8(const float* W, int K, int N, int k0, int nsrc0, unsigned char* WT, int drow0, const float* gain, float scale, LAS float* scr, int lane) {
    f32x4 ld[8];
#pragma unroll
    for (int i = 0; i < 8; ++i) ld[i] = *(const f32x4*)(W + (size_t)(k0 + 8 * i + (lane >> 3)) * N + nsrc0 + 4 * (lane & 7));
#pragma unroll
    for (int i = 0; i < 8; ++i) { const int kk = 8 * i + (lane >> 3); f32x4 v = ld[i] * scale; if (gain) v *= gain[k0 + kk]; LAS float* d = scr + kk * 33 + 4 * (lane & 7); d[0] = v[0]; d[1] = v[1]; d[2] = v[2]; d[3] = v[3]; }
    LDS_WAIT(); asm volatile("" ::: "memory");
    const int c = lane & 7;
#pragma unroll
    for (int j = 0; j < 4; ++j) { const int n = (lane >> 3) + 8 * j; const LAS float* s = scr + (8 * c) * 33 + n;
        u32x2 o; o.x = pk4_fp8(s[0 * 33], s[1 * 33], s[2 * 33], s[3 * 33]); o.y = pk4_fp8(s[4 * 33], s[5 * 33], s[6 * 33], s[7 * 33]);
        *(GAS u32x2*)(WT + (size_t)(drow0 + n) * K + k0 + 8 * c) = o; }
    LDS_WAIT(); asm volatile("" ::: "memory");
}
template <int MAP>
__device__ __forceinline__ void transpose_mat(const float* W, int K, int N, int ncol0, int ncols, bf16_t* WT, int roff, const float* gain, LAS float* scr, int lane, int it) {
    const int nblk = ncols / 32, kb = it / nblk, nb = it % nblk, n = 32 * nb;
    int drow;
    if (MAP == 0) drow = roff + n;
    else if (MAP == 1) drow = (n / 128) * 256 + roff + (n % 128);
    else { const int head = n / 64, d = n % 64; drow = roff + (head / 4) * 256 + (d / 32) * 128 + (head % 4) * 32; }
    transpose_item(W, K, N, 64 * kb, ncol0 + n, WT, drow, gain, scr, lane);
}

namespace epi {
using pg8::Unit;
#define EPI_ARGS const f32x4 (&acc)[2][2][4][2], const Unit& u, int wr, int wc, int fr, int fq, const LAS unsigned char* pre
__device__ __forceinline__ u32x4 pack8(f32x4 v0, f32x4 v1) { u32x4 w; w.x = cvt_pk_bf16(v0[0], v0[1]); w.y = cvt_pk_bf16(v0[2], v0[3]); w.z = cvt_pk_bf16(v1[0], v1[1]); w.w = cvt_pk_bf16(v1[2], v1[3]); return w; }
__device__ __forceinline__ void unpack8(u32x4 w, f32x4& v0, f32x4& v1) { v0 = (f32x4){bf_lo(w.x), bf_hi(w.x), bf_lo(w.y), bf_hi(w.y)}; v1 = (f32x4){bf_lo(w.z), bf_hi(w.z), bf_lo(w.w), bf_hi(w.w)}; }
__device__ __forceinline__ f32x4 silu4(f32x4 v) { return (f32x4){silu_f(v[0]), silu_f(v[1]), silu_f(v[2]), silu_f(v[3])}; }
__device__ __forceinline__ float sumsq4(f32x4 v) { return (v[0] * v[0] + v[1] * v[1]) + (v[2] * v[2] + v[3] * v[3]); }

struct EpiOG {
    static constexpr int PRE = 0;
    bf16_t* OG1;
    __device__ __forceinline__ void operator()(EPI_ARGS) const {
        const int colt = u.pn * 256 + wc * 32 + 8 * fq;
#pragma unroll
        for (int ai = 0; ai < 2; ++ai)
#pragma unroll
            for (int m = 0; m < 4; ++m) { bf16_t* rowp = OG1 + (size_t)(u.pm * 256 + ai * 128 + wr * 64 + m * 16 + fr) * D + colt;
#pragma unroll
                for (int bj = 0; bj < 2; ++bj) *(u32x4*)(rowp + bj * 128) = pack8(silu4(acc[ai][bj][m][0]), silu4(acc[ai][bj][m][1])); }
    }
};
struct EpiQFI {
    static constexpr int PRE = 0;
    unsigned short* base3; const float* LB;
    __device__ __forceinline__ void operator()(EPI_ARGS) const {
        const int kind = u.pm >> 2; unsigned short* base = base3 + (size_t)kind * (size_t)(64u << 20);
        const size_t toff = (size_t)(u.pn * 4 + (wc >> 1)) * 65536 + (wc & 1) * 32 + 8 * fq;
        if (kind == 1) { float lbr[2][4];
#pragma unroll
            for (int ai = 0; ai < 2; ++ai)
#pragma unroll
                for (int m = 0; m < 4; ++m) lbr[ai][m] = LB[(u.pm & 3) * 256 + ai * 128 + wr * 64 + m * 16 + fr];
#pragma unroll
            for (int ai = 0; ai < 2; ++ai)
#pragma unroll
                for (int m = 0; m < 4; ++m) { const int ch = (u.pm & 3) * 256 + ai * 128 + wr * 64 + m * 16 + fr; unsigned short* rowp = base + toff + (size_t)ch * 64; const float lb = lbr[ai][m], om = 1.0f - lb;
#pragma unroll
                    for (int bj = 0; bj < 2; ++bj) { u32x4 w;
#pragma unroll
                        for (int n = 0; n < 2; ++n) { float g[4];
#pragma unroll
                            for (int i = 0; i < 4; ++i) { const float v = acc[ai][bj][m][n][i]; const float sg = fast_rcp(1.0f + fast_exp(-v)); g[i] = __builtin_amdgcn_logf(lb + om * sg) * 0.6931471805599453f; }
                            w[2 * n] = pk_f16(g[0], g[1]); w[2 * n + 1] = pk_f16(g[2], g[3]); }
                        *(u32x4*)(rowp + bj * 131072) = w; } } }
        else {
#pragma unroll
            for (int ai = 0; ai < 2; ++ai)
#pragma unroll
                for (int m = 0; m < 4; ++m) { const int ch = (u.pm & 3) * 256 + ai * 128 + wr * 64 + m * 16 + fr; unsigned short* rowp = base + toff + (size_t)ch * 64;
#pragma unroll
                    for (int bj = 0; bj < 2; ++bj) *(u32x4*)(rowp + bj * 131072) = pack8(acc[ai][bj][m][0], acc[ai][bj][m][1]); } }
    }
};
template <int BASE, bool OUT32, bool OUT8 = false> struct EpiRes {
    static constexpr int PRE = 0;
    static constexpr bool BASE32 = BASE == 1;
    const void* base; bf16_t* out; float* out32; u64* rowss; unsigned char* out8; const float* invr; const float* invg;
    __device__ __forceinline__ void operator()(EPI_ARGS) const {
        const int colt = u.pn * 256 + wc * 32 + 8 * fq; float ssr[2][4];
        constexpr int MB = BASE32 ? 2 : 4;
        f32x4 ig[2][2]; float irr[2][4];
        if (BASE == 2) {
#pragma unroll
            for (int bj = 0; bj < 2; ++bj) { ig[bj][0] = *(const f32x4*)(invg + colt + bj * 128); ig[bj][1] = *(const f32x4*)(invg + colt + bj * 128 + 4); }
#pragma unroll
            for (int ai = 0; ai < 2; ++ai)
#pragma unroll
                for (int m = 0; m < 4; ++m) irr[ai][m] = invr[u.pm * 256 + ai * 128 + wr * 64 + m * 16 + fr]; }
#pragma unroll
        for (int ai = 0; ai < 2; ++ai)
#pragma unroll
            for (int m0 = 0; m0 < 4; m0 += MB) { u32x4 bw[MB][2][BASE32 ? 2 : 1];
#pragma unroll
                for (int mi = 0; mi < MB; ++mi) { const size_t off = (size_t)(u.pm * 256 + ai * 128 + wr * 64 + (m0 + mi) * 16 + fr) * D + colt;
#pragma unroll
                    for (int bj = 0; bj < 2; ++bj) {
                        if (BASE32) { const float* bp = (const float*)base + off + bj * 128; bw[mi][bj][0] = *(const u32x4*)bp; bw[mi][bj][BASE32 ? 1 : 0] = *(const u32x4*)(bp + 4); }
                        else bw[mi][bj][0] = *(const u32x4*)((const bf16_t*)base + off + bj * 128); } }
#pragma unroll
                for (int mi = 0; mi < MB; ++mi) { const int m = m0 + mi; const size_t off = (size_t)(u.pm * 256 + ai * 128 + wr * 64 + m * 16 + fr) * D + colt; float ss = 0.f;
#pragma unroll
                    for (int bj = 0; bj < 2; ++bj) { f32x4 b0, b1;
                        if (BASE32) { b0 = __builtin_bit_cast(f32x4, bw[mi][bj][0]); b1 = __builtin_bit_cast(f32x4, bw[mi][bj][BASE32 ? 1 : 0]); }
                        else unpack8(bw[mi][bj][0], b0, b1);
                        if (BASE == 2) { const float ir = irr[ai][m]; b0 = b0 * ir * ig[bj][0]; b1 = b1 * ir * ig[bj][1]; }
                        const f32x4 h0 = acc[ai][bj][m][0] + b0, h1 = acc[ai][bj][m][1] + b1; ss += sumsq4(h0) + sumsq4(h1);
                        *(u32x4*)(out + off + bj * 128) = pack8(h0, h1);
                        if (OUT8) { u32x2 w8; w8.x = pk4_fp8(h0[0] * S8_H3, h0[1] * S8_H3, h0[2] * S8_H3, h0[3] * S8_H3); w8.y = pk4_fp8(h1[0] * S8_H3, h1[1] * S8_H3, h1[2] * S8_H3, h1[3] * S8_H3); *(u32x2*)(out8 + off + bj * 128) = w8; }
                        if (OUT32) { float* op = out32 + off + bj * 128; *(f32x4*)op = h0; *(f32x4*)(op + 4) = h1; } }
                    ss += __shfl_xor(ss, 16); ss += __shfl_xor(ss, 32); ssr[ai][m] = ss; } }
        if (fq == 0) {
#pragma unroll
            for (int ai = 0; ai < 2; ++ai)
#pragma unroll
                for (int m = 0; m < 4; ++m) __hip_atomic_fetch_add(rowss + u.pm * 256 + ai * 128 + wr * 64 + m * 16 + fr, (u64)(ssr[ai][m] * SS_FIX), RLX_AGENT); }
    }
};
template <bool MOE> struct EpiGU {
    static constexpr int PRE = MOE ? 4 : 8;
    __device__ __forceinline__ const void* pre_src(const Unit& u) const { return MOE ? (const void*)((const float*)rsrc + u.pm * 256) : (const void*)((const u64*)rsrc + u.pm * 256); }
    bf16_t* hid; int ldh; const void* rsrc;
    __device__ __forceinline__ void operator()(EPI_ARGS) const {
        const int colt = u.pn * 128 + wc * 32 + 8 * fq; float rr[2][4];
#pragma unroll
        for (int ai = 0; ai < 2; ++ai)
#pragma unroll
            for (int m = 0; m < 4; ++m) { const int rl = ai * 128 + wr * 64 + m * 16 + fr; rr[ai][m] = MOE ? *(const LAS float*)(pre + rl * 4) : rinv_of(*(const LAS u64*)(pre + rl * 8)); }
#pragma unroll
        for (int ai = 0; ai < 2; ++ai)
#pragma unroll
            for (int m = 0; m < 4; ++m) { const int row = u.pm * 256 + ai * 128 + wr * 64 + m * 16 + fr;
                const float r = rr[ai][m];
                const float c1 = r * r * (MOE ? S8_HID : 1.0f), c2 = -r * LOG2E; f32x4 o[2];
#pragma unroll
                for (int n = 0; n < 2; ++n) { const f32x4 ga = acc[ai][0][m][n]; const f32x4 p = ga * acc[ai][1][m][n] * c1; const f32x4 t = ga * c2;
                    f32x4 e = {__builtin_amdgcn_exp2f(t[0]), __builtin_amdgcn_exp2f(t[1]), __builtin_amdgcn_exp2f(t[2]), __builtin_amdgcn_exp2f(t[3])}; e = e + 1.0f;
                    const f32x4 sg = {fast_rcp(e[0]), fast_rcp(e[1]), fast_rcp(e[2]), fast_rcp(e[3])}; o[n] = p * sg; }
                if (MOE) { u32x2 w8; w8.x = pk4_fp8(clamp8(o[0][0]), clamp8(o[0][1]), clamp8(o[0][2]), clamp8(o[0][3]));
                    w8.y = pk4_fp8(clamp8(o[1][0]), clamp8(o[1][1]), clamp8(o[1][2]), clamp8(o[1][3])); *(u32x2*)((unsigned char*)hid + (size_t)row * ldh + colt) = w8; }
                else *(u32x4*)(hid + (size_t)row * ldh + colt) = pack8(o[0], o[1]); }
    }
};
struct EpiQK {
    static constexpr int PRE = 0;
    bf16_t* Q2; bf16_t* K2; const u64* rowss; const float* qgain; const float* kgain;
    __device__ __forceinline__ void operator()(EPI_ARGS) const {
        const bool isq = u.pn < 4; const float* gn = isq ? qgain : kgain; const float osc = isq ? 0.125f * LOG2E : 1.0f;
        f32x4 gv[2][2];
#pragma unroll
        for (int bj = 0; bj < 2; ++bj)
#pragma unroll
            for (int n = 0; n < 2; ++n) gv[bj][n] = *(const f32x4*)(gn + 32 * bj + 8 * fq + 4 * n) * osc;
        bf16_t* base = isq ? Q2 + (size_t)(4 * u.pn + wc) * 64 + 8 * fq : K2 + (size_t)wc * 64 + 8 * fq; const int ld = isq ? D : 256; float rr[2][4];
#pragma unroll
        for (int ai = 0; ai < 2; ++ai)
#pragma unroll
            for (int m = 0; m < 4; ++m) rr[ai][m] = rinv_of(rowss[u.pm * 256 + ai * 128 + wr * 64 + m * 16 + fr]);
#pragma unroll
        for (int ai = 0; ai < 2; ++ai)
#pragma unroll
            for (int m = 0; m < 4; ++m) { const int row = u.pm * 256 + ai * 128 + wr * 64 + m * 16 + fr;
                const float r = rr[ai][m];
                f32x4 y[2][2]; float ss = 0.f;
#pragma unroll
                for (int bj = 0; bj < 2; ++bj)
#pragma unroll
                    for (int n = 0; n < 2; ++n) { y[bj][n] = acc[ai][bj][m][n] * r; ss += sumsq4(y[bj][n]); }
                ss += __shfl_xor(ss, 16); ss += __shfl_xor(ss, 32);
                const float s = __builtin_amdgcn_rsqf(ss * (1.0f / HD) + EPS);
#pragma unroll
                for (int bj = 0; bj < 2; ++bj) *(u32x4*)(base + (size_t)row * ld + 32 * bj) = pack8(y[bj][0] * s * gv[bj][0], y[bj][1] * s * gv[bj][1]); }
    }
};
struct EpiVT {
    static constexpr int PRE = 0;
    bf16_t* VT2; const u64* rowss;
    __device__ __forceinline__ void operator()(EPI_ARGS) const {
        const int tcol = u.pn * 256 + wc * 32 + 8 * fq; f32x4 rv[2][2];
#pragma unroll
        for (int bj = 0; bj < 2; ++bj)
#pragma unroll
            for (int n = 0; n < 2; ++n) {
#pragma unroll
                for (int i = 0; i < 4; ++i) rv[bj][n][i] = rinv_of(rowss[tcol + bj * 128 + 4 * n + i]); }
        const size_t toff = (size_t)(u.pn * 4 + (wc >> 1)) * 16384 + (wc & 1) * 32 + 8 * fq;
#pragma unroll
        for (int ai = 0; ai < 2; ++ai)
#pragma unroll
            for (int m = 0; m < 4; ++m) { const int ch = ai * 128 + wr * 64 + m * 16 + fr; bf16_t* rowp = VT2 + toff + (size_t)ch * 64;
#pragma unroll
                for (int bj = 0; bj < 2; ++bj) *(u32x4*)(rowp + bj * 32768) = pack8(acc[ai][bj][m][0] * rv[bj][0], acc[ai][bj][m][1] * rv[bj][1]); }
    }
};
template <bool FIRST> struct EpiMoeDown {
    static constexpr int PRE = 0;
    float* out; const int* rtok; const float* rg; bf16_t* h3b; unsigned char* dummy;
    __device__ __forceinline__ void operator()(EPI_ARGS) const {
        const int colt = u.pn * 256 + wc * 32 + 8 * fq; int tk[2][4]; float gt[2][4];
#pragma unroll
        for (int ai = 0; ai < 2; ++ai)
#pragma unroll
            for (int m = 0; m < 4; ++m) { const int prow = u.pm * 256 + ai * 128 + wr * 64 + m * 16 + fr; tk[ai][m] = rtok[prow]; gt[ai][m] = rg[prow]; }
#pragma unroll
        for (int ai = 0; ai < 2; ++ai) { u32x4 bw[4][2];
#pragma unroll
            for (int m = 0; m < 4; ++m) { const int tok = tk[ai][m]; const size_t off = (size_t)(tok < 0 ? 0 : tok) * D + colt;
#pragma unroll
                for (int bj = 0; bj < 2; ++bj) bw[m][bj] = *(const u32x4*)(h3b + off + bj * 128); }
#pragma unroll
            for (int m = 0; m < 4; ++m) { const int tok = tk[ai][m]; const float g = gt[ai][m]; const size_t off = (size_t)(tok < 0 ? 0 : tok) * D + colt;
                bf16_t* pb = tok < 0 ? (bf16_t*)dummy + (colt & 1023) : h3b + off; float* pf = tok < 0 ? (float*)dummy + (colt & 1023) : out + off;
#pragma unroll
                for (int bj = 0; bj < 2; ++bj) { f32x4 o0, o1; unpack8(bw[m][bj], o0, o1); o0 += acc[ai][bj][m][0] * g; o1 += acc[ai][bj][m][1] * g;
                    if (FIRST) *(u32x4*)(pb + bj * 128) = pack8(o0, o1);
                    else { float* p = pf + bj * 128; *(f32x4*)p = o0; *(f32x4*)(p + 4) = o1; } } } }
    }
};
#undef EPI_ARGS
}

struct Ptrs {
    const float *x, *w_in, *hlb, *gnorm, *w_out, *w_q, *q_gain, *sink, *w_o, *kv_norm, *kv_w, *k_gain, *rel_bias, *attn_norm, *ffn_norm, *ffn_wg, *ffn_wu, *ffn_wd, *router, *moe_wg, *moe_wu, *moe_wd;
    float* out; unsigned char* ws;
};
__device__ __forceinline__ void p0_prologue(Frame& F, const Ptrs& P) {
    unsigned char* ws = P.ws;
    const int tid_ = fresh_tid(), lane = tid_ & 63, wave_ = __builtin_amdgcn_readfirstlane(tid_ >> 6);
    LAS float* scr = (LAS float*)(F.lds + wave_ * 16384);
    const int gw = F.vcu * 8 + wave_, NGW = F.G * 8;
    constexpr int I_QO = 16 * 32, I_FI = 16 * 96, I_OUT = 16 * 32, I_G = 16 * 88, I_DN = 44 * 32, I_Q = 16 * 32, I_KV = 16 * 16, I_O = 16 * 32;
    constexpr int I_MG = 16 * 112, I_MD = 56 * 32;
    constexpr int N_SMALL = I_QO + I_FI + I_OUT + 2 * I_G + I_DN + I_Q + I_KV + I_O;
    constexpr int N_MOE = NE * (2 * I_MG + I_MD);
    struct TItem { const float* src; int K, N, k0, drow0, fp8; unsigned char* dst; const float* gain; float scale; };
    auto decode = [&](int it) -> TItem {
        TItem t; t.gain = nullptr; t.scale = 1.0f; t.fp8 = 0; int r = it;
#define TI_SET(W_, K_, N_, kb_, nsrc_, dst_, drow_) do { t.src = (W_) + (nsrc_); t.K = (K_); t.N = (N_); t.k0 = 64 * (kb_); t.dst = (unsigned char*)(dst_); t.drow0 = (drow_); } while (0)
        if (r < I_QO) { const int kb = r / 32, n = 32 * (r % 32); TI_SET(P.w_in, D, 4 * D, kb, 3072 + n, ws + WS_WQO, n); return t; } r -= I_QO;
        if (r < I_FI) { const int kb = r / 96, n = 32 * (r % 96); TI_SET(P.w_in, D, 4 * D, kb, n, ws + WS_WFI, n); return t; } r -= I_FI;
        if (r < I_OUT) { const int kb = r / 32, n = 32 * (r % 32); TI_SET(P.w_out, D, D, kb, n, ws + WS_WOUT, n); return t; } r -= I_OUT;
        if (r < 2 * I_G) { const bool up = r >= I_G; if (up) r -= I_G; const int kb = r / 88, n = 32 * (r % 88);
            TI_SET(up ? P.ffn_wu : P.ffn_wg, D, FF0, kb, n, ws + WS_WGU, (n / 128) * 256 + (up ? 128 : 0) + (n % 128)); t.gain = P.ffn_norm; return t; } r -= 2 * I_G;
        if (r < I_DN) { const int kb = r / 32, n = 32 * (r % 32); TI_SET(P.ffn_wd, FF0, D, kb, n, ws + WS_WDN, n); return t; } r -= I_DN;
        if (r < I_Q) { const int kb = r / 32, n = 32 * (r % 32), head = n / 64, d = n % 64;
            TI_SET(P.w_q, D, D, kb, n, ws + WS_WQK, (head / 4) * 256 + (d / 32) * 128 + (head % 4) * 32); t.gain = P.attn_norm + D; return t; } r -= I_Q;
        if (r < I_KV) { const int kb = r / 16, n = 32 * (r % 16);
            if (n < 256) { const int head = n / 64, d = n % 64; TI_SET(P.kv_w, D, 512, kb, n, ws + WS_WQK, 1024 + (d / 32) * 128 + head * 32); }
            else TI_SET(P.kv_w, D, 512, kb, n, ws + WS_WV, n - 256);
            t.gain = P.kv_norm; return t; } r -= I_KV;
        if (r < I_O) { const int kb = r / 32, n = 32 * (r % 32); TI_SET(P.w_o, D, D, kb, n, ws + WS_WO, n); return t; } r -= I_O;
        const int e = r / (2 * I_MG + I_MD); r -= e * (2 * I_MG + I_MD); t.fp8 = 1;
        if (r < 2 * I_MG) { const bool up = r >= I_MG; if (up) r -= I_MG; const int kb = r / (FFE / 32), n = 32 * (r % (FFE / 32));
            TI_SET((up ? P.moe_wu : P.moe_wg) + (size_t)e * D * FFE, D, FFE, kb, n, ws + WS_MGU + (size_t)e * 2 * FFE * D, (n / 128) * 256 + (up ? 128 : 0) + (n % 128)); t.gain = P.ffn_norm + D; t.scale = S8_WGU; return t; } r -= 2 * I_MG;
        { const int kb = r / 32, n = 32 * (r % 32); TI_SET(P.moe_wd + (size_t)e * FFE * D, FFE, D, kb, n, ws + WS_MDN + (size_t)e * D * FFE, n); t.scale = S8_WDN; }
#undef TI_SET
        return t; };
#define TI_LOAD(t_, ld_) do { _Pragma("unroll") for (int i_ = 0; i_ < 8; ++i_) ld_[i_] = *(const f32x4*)((t_).src + (size_t)((t_).k0 + 8 * i_ + (lane >> 3)) * (t_).N + 4 * (lane & 7)); } while (0)
    f32x4 ldc[8], ldn[8];
    int it = gw; TItem cur{}; if (it < N_SMALL + N_MOE) { cur = decode(it); TI_LOAD(cur, ldc); }
    for (; it < N_SMALL + N_MOE; it += NGW) {
        const bool more = it + NGW < N_SMALL + N_MOE; TItem nxt = cur;
        if (more) { nxt = decode(it + NGW); TI_LOAD(nxt, ldn); }
#pragma unroll
        for (int i = 0; i < 8; ++i) { const int kk = 8 * i + (lane >> 3); f32x4 v = ldc[i] * cur.scale; if (cur.gain) v *= cur.gain[cur.k0 + kk]; LAS float* d = scr + kk * 33 + 4 * (lane & 7); d[0] = v[0]; d[1] = v[1]; d[2] = v[2]; d[3] = v[3]; }
        LDS_WAIT(); asm volatile("" ::: "memory");
        { const int c = lane & 7;
#pragma unroll
          for (int j = 0; j < 4; ++j) { const int n = (lane >> 3) + 8 * j; const LAS float* sp = scr + (8 * c) * 33 + n;
              if (cur.fp8) { u32x2 o; o.x = pk4_fp8(sp[0 * 33], sp[1 * 33], sp[2 * 33], sp[3 * 33]); o.y = pk4_fp8(sp[4 * 33], sp[5 * 33], sp[6 * 33], sp[7 * 33]);
                  *(GAS u32x2*)(cur.dst + (size_t)(cur.drow0 + n) * cur.K + cur.k0 + 8 * c) = o; }
              else { u32x4 o; o.x = pk2(sp[0 * 33], sp[1 * 33]); o.y = pk2(sp[2 * 33], sp[3 * 33]); o.z = pk2(sp[4 * 33], sp[5 * 33]); o.w = pk2(sp[6 * 33], sp[7 * 33]);
                  *(GAS u32x4*)((bf16_t*)cur.dst + (size_t)(cur.drow0 + n) * cur.K + cur.k0 + 8 * c) = o; } } }
        LDS_WAIT(); asm volatile("" ::: "memory");
        cur = nxt;
#pragma unroll
        for (int i = 0; i < 8; ++i) ldc[i] = ldn[i];
    }
#undef TI_LOAD
    if (blockIdx.x == 0) { for (int c = tid_; c < D; c += 512) { ((float*)(ws + WS_INVG))[c] = 1.0f / P.attn_norm[c]; const float a = P.hlb[c], b = P.hlb[D + c], d = P.hlb[2 * D + c]; const float mx = fmaxf(a, fmaxf(b, d));
        const float ea = __expf(a - mx), eb = __expf(b - mx), ed = __expf(d - mx); ((float*)(ws + WS_LB))[c] = ea / (ea + eb + ed); } }
    bf16_t* XN = (bf16_t*)(ws + WS_XN);
    f32x4 gn[4];
#pragma unroll
    for (int j = 0; j < 4; ++j) gn[j] = ((const f32x4*)P.attn_norm)[lane + 64 * j];
    for (int m = 2 * gw; m < T; m += 2 * NGW) {
        f32x4 v[2][4]; float sq[2];
#pragma unroll
        for (int rr = 0; rr < 2; ++rr) { const GAS f32x4* xr = (const GAS f32x4*)(P.x + (size_t)(m + rr) * D) + lane;
#pragma unroll
            for (int j = 0; j < 4; ++j) v[rr][j] = xr[64 * j]; }
#pragma unroll
        for (int rr = 0; rr < 2; ++rr) { float a = 0.f;
#pragma unroll
            for (int j = 0; j < 4; ++j) a += (v[rr][j][0] * v[rr][j][0] + v[rr][j][1] * v[rr][j][1]) + (v[rr][j][2] * v[rr][j][2] + v[rr][j][3] * v[rr][j][3]);
            sq[rr] = a; }
#pragma unroll
        for (int o = 1; o < 64; o <<= 1) { sq[0] += __shfl_xor(sq[0], o); sq[1] += __shfl_xor(sq[1], o); }
#pragma unroll
        for (int rr = 0; rr < 2; ++rr) { const float r = __builtin_amdgcn_rsqf(sq[rr] * (1.f / D) + EPS); if (lane == 0) ((float*)(ws + WS_INVR0))[m + rr] = 1.0f / r;
            GAS u32x2* o8 = (GAS u32x2*)(XN + (size_t)(m + rr) * D) + lane;
#pragma unroll
            for (int j = 0; j < 4; ++j) { const f32x4 y = v[rr][j] * r * gn[j]; u32x2 w; w.x = cvt_pk_bf16(y[0], y[1]); w.y = cvt_pk_bf16(y[2], y[3]); o8[64 * j] = w; } }
    }
}

__device__ __forceinline__ void scan_state_pass(Frame& F, const unsigned short* GT, const bf16_t* VT, float* SST) {
    constexpr int KP = 144, L_K = 0, L_V = 32 * KP, L_D = L_V + 128 * KP, BUF = L_D + 128;
    LAS unsigned char* lds = F.lds;
    const int tid = fresh_tid(), lane = tid & 63, w = __builtin_amdgcn_readfirstlane(tid >> 6), l15 = lane & 15, g = lane >> 4, ch = tid >> 4, sg = tid & 15;
    for (int item = F.vcu; item < BATCH * HG_H * 4; item += F.G) {
        const int bh = item >> 2, kq = item & 3, b = bh >> 3, h = bh & 7;
        const size_t blk0 = (size_t)b * NCHK;
        const unsigned short* gsrc = GT + (blk0 * 1024 + h * 128 + 32 * kq + ch) * 64 + 4 * sg;
        const bf16_t* vsrc = VT + (blk0 * 1024 + h * 128) * 64 + (size_t)tid * 8;
        u32x2 rg[2]; u32x4 rv[2][2];
#define SP_LOAD(set, cc) do { rg[set] = *(const u32x2*)(gsrc + (size_t)(cc) * 65536); rv[set][0] = *(const u32x4*)(vsrc + (size_t)(cc) * 65536); rv[set][1] = *(const u32x4*)(vsrc + (size_t)(cc) * 65536 + 4096); } while (0)
        f32x4 S[2]; S[0] = (f32x4){0.f, 0.f, 0.f, 0.f}; S[1] = S[0];
        SP_LOAD(0, 0); SP_LOAD(1, 1);
#define SP_ELEM(set, cc) do { LAS unsigned char* bf_ = lds + (set) * BUF; \
            { const unsigned w0_ = rg[set].x, w1_ = rg[set].y;   const f16x2 p0 = __builtin_bit_cast(f16x2, w0_), p1 = __builtin_bit_cast(f16x2, w1_); const float gl0 = (float)p0[0], gl1 = (float)p0[1], gl2 = (float)p1[0], gl3 = (float)p1[1]; \
              const float c0 = gl0, c1 = c0 + gl1, c2 = c1 + gl2, c3 = c2 + gl3; float inc = c3; \
              _Pragma("unroll") for (int o_ = 1; o_ < 16; o_ <<= 1) { const float up = __shfl_up(inc, o_, 16); if (sg >= o_) inc += up; } \
              const float bl = __shfl(inc, 15, 16), off = inc - c3; \
              const float k0 = (1.0f - fast_exp(gl0)) * fast_exp(bl - (off + c0)), k1 = (1.0f - fast_exp(gl1)) * fast_exp(bl - (off + c1)), k2 = (1.0f - fast_exp(gl2)) * fast_exp(bl - (off + c2)), k3 = (1.0f - fast_exp(gl3)) * fast_exp(bl - (off + c3)); \
              u32x2 kw; kw.x = cvt_pk_bf16(k0, k1); kw.y = cvt_pk_bf16(k2, k3); *(LAS u32x2*)(bf_ + L_K + ch * KP + sg * 8) = kw; \
              if (sg == 0) *(LAS float*)(bf_ + L_D + ch * 4) = fast_exp(bl); } \
            *(LAS u32x4*)(bf_ + L_V + (tid >> 3) * KP + (tid & 7) * 16) = rv[set][0]; *(LAS u32x4*)(bf_ + L_V + (64 + (tid >> 3)) * KP + (tid & 7) * 16) = rv[set][1]; \
            if ((cc) + 2 < NCHK) SP_LOAD(set, (cc) + 2); } while (0)
#define SP_MMA(set, cc) do { const LAS unsigned char* bf_ = lds + (set) * BUF; \
            _Pragma("unroll") for (int kt = 0; kt < 2; ++kt) { const f32x4 dv = *(const LAS f32x4*)(bf_ + L_D + (16 * kt + 4 * g) * 4); f32x4 cacc = S[kt] * dv; \
                _Pragma("unroll") for (int s2 = 0; s2 < 2; ++s2) { const bf16x8 a_ = *(const LAS bf16x8*)(bf_ + L_K + (16 * kt + l15) * KP + (32 * s2 + 8 * g) * 2); const bf16x8 b_ = *(const LAS bf16x8*)(bf_ + L_V + (16 * w + l15) * KP + (32 * s2 + 8 * g) * 2); \
                    cacc = __builtin_amdgcn_mfma_f32_16x16x32_bf16(a_, b_, cacc, 0, 0, 0); } \
                S[kt] = cacc; } \
            if ((((cc) & 7) == 7) && (cc) + 1 < NCHK) { float* dst = SST + (((size_t)bh * 16 + (((cc) + 1) >> 3)) * 128 + 32 * kq) * 128 + 16 * w + l15; \
                _Pragma("unroll") for (int kt = 0; kt < 2; ++kt) _Pragma("unroll") for (int r = 0; r < 4; ++r) dst[(size_t)(16 * kt + 4 * g + r) * 128] = S[kt][r]; } } while (0)
        for (int c = 0; c < NCHK; c += 2) {
            SP_ELEM(0, c); LDS_WAIT(); __syncthreads(); SP_MMA(0, c);
            SP_ELEM(1, c + 1); LDS_WAIT(); __syncthreads(); SP_MMA(1, c + 1); }
        __syncthreads();
#undef SP_LOAD
#undef SP_ELEM
#undef SP_MMA
    }
}
__device__ __forceinline__ void scan_output_pass(Frame& F, const bf16_t* QT, const unsigned short* GT, const bf16_t* VT, const float* SST, const bf16_t* OG1, const float* gnorm, bf16_t* OGATED) {
    constexpr int QP = 272, KP = 144, OP = 528, L_QE = 0, L_KE = 64 * QP, L_KD = 2 * 64 * QP, L_VT = L_KD + 128 * KP, L_O = L_VT + 128 * KP, L_D = L_O + 64 * OP, L_RED = L_D + 512;
    static_assert(L_RED + 1024 <= RING_BYTES, "scan LDS");
    LAS unsigned char* lds = F.lds;
    const int tid = fresh_tid(), lane = tid & 63, w = __builtin_amdgcn_readfirstlane(tid >> 6), l31 = lane & 31, hh = lane >> 5, ch = tid >> 2, seg = tid & 3, tt = w & 1, et = w >> 1;
    const int ft = tid >> 3, fe = tid & 7;
    for (int item = F.vcu; item < BATCH * HG_H * 16; item += F.G) {
        const int bh = item >> 4, sc = item & 15, b = bh >> 3, h = bh & 7;
        const size_t blk0 = (size_t)b * NCHK + (size_t)sc * 8;
        f32x16 S[4];
        if (sc == 0) {
#pragma unroll
            for (int kt = 0; kt < 4; ++kt) S[kt] = (f32x16){};
        } else { const float* src = SST + (((size_t)bh * 16 + sc) * 128) * 128 + 32 * et + l31;
#pragma unroll
            for (int kt = 0; kt < 4; ++kt)
#pragma unroll
                for (int r = 0; r < 16; ++r) S[kt][r] = src[(size_t)(32 * kt + (r & 3) + 8 * (r >> 2) + 4 * hh) * 128]; }
        const size_t tile0 = (blk0 * 1024 + h * 128) * 64;
        u32x4 pg[2], pq[2], pvv[2];
#define OP_LOAD(cc) do { const size_t to_ = tile0 + (size_t)(cc) * 65536; const u32x4* gp_ = (const u32x4*)(GT + to_ + ch * 64 + 16 * seg); pg[0] = gp_[0]; pg[1] = gp_[1]; \
            const u32x4* qp_ = (const u32x4*)(QT + to_ + ch * 64 + 16 * seg); pq[0] = qp_[0]; pq[1] = qp_[1]; \
            pvv[0] = *(const u32x4*)(VT + to_ + (size_t)tid * 8); pvv[1] = *(const u32x4*)(VT + to_ + (size_t)tid * 8 + 4096); } while (0)
        OP_LOAD(0);
        for (int c = 0; c < 8; ++c) {
            float gl[16], qv[16];
            { const unsigned gw_[8] = {pg[0].x, pg[0].y, pg[0].z, pg[0].w, pg[1].x, pg[1].y, pg[1].z, pg[1].w}; const unsigned qw_[8] = {pq[0].x, pq[0].y, pq[0].z, pq[0].w, pq[1].x, pq[1].y, pq[1].z, pq[1].w};
#pragma unroll
              for (int i = 0; i < 8; ++i) { const f16x2 p = __builtin_bit_cast(f16x2, gw_[i]); gl[2 * i] = (float)p[0]; gl[2 * i + 1] = (float)p[1]; qv[2 * i] = bf_lo(qw_[i]); qv[2 * i + 1] = bf_hi(qw_[i]); } }
            float cs[16]; { float a = 0.f;
#pragma unroll
              for (int i = 0; i < 16; ++i) { a += gl[i]; cs[i] = a; } }
            float inc = cs[15]; { const float u1 = __shfl_up(inc, 1, 4); if (seg >= 1) inc += u1; const float u2 = __shfl_up(inc, 2, 4); if (seg >= 2) inc += u2; }
            const float blast = __shfl(inc, 3, 4), off = inc - cs[15];
            unsigned kdw[8];
#pragma unroll
            for (int i = 0; i < 16; i += 2) { float kd2[2], qe2[2], ke2[2];
#pragma unroll
                for (int j = 0; j < 2; ++j) { const int ii = i + j; const float bt = off + cs[ii]; const float kk = 1.0f - fast_exp(gl[ii]);
                    qe2[j] = qv[ii] * fast_exp(bt); ke2[j] = kk * fast_exp(-fmaxf(bt, -80.f)); kd2[j] = kk * fast_exp(blast - bt); }
                const unsigned qw = cvt_pk_bf16(qe2[0], qe2[1]), kw = cvt_pk_bf16(ke2[0], ke2[1]); const int t = 16 * seg + i;
                *(LAS bf16_t*)(lds + L_QE + t * QP + ch * 2) = (bf16_t)qw; *(LAS bf16_t*)(lds + L_QE + (t + 1) * QP + ch * 2) = (bf16_t)(qw >> 16);
                *(LAS bf16_t*)(lds + L_KE + t * QP + ch * 2) = (bf16_t)kw; *(LAS bf16_t*)(lds + L_KE + (t + 1) * QP + ch * 2) = (bf16_t)(kw >> 16);
                kdw[i >> 1] = cvt_pk_bf16(kd2[0], kd2[1]); }
            *(LAS u32x4*)(lds + L_KD + ch * KP + seg * 32) = (u32x4){kdw[0], kdw[1], kdw[2], kdw[3]}; *(LAS u32x4*)(lds + L_KD + ch * KP + seg * 32 + 16) = (u32x4){kdw[4], kdw[5], kdw[6], kdw[7]};
            if (seg == 0) *(LAS float*)(lds + L_D + ch * 4) = fast_exp(blast);
            *(LAS u32x4*)(lds + L_VT + (tid >> 3) * KP + (tid & 7) * 16) = pvv[0]; *(LAS u32x4*)(lds + L_VT + (64 + (tid >> 3)) * KP + (tid & 7) * 16) = pvv[1];
            if (c + 1 < 8) OP_LOAD(c + 1);
            const u32x4* ogp = (const u32x4*)(OG1 + ((blk0 + c) * 64 + ft) * D + h * 128 + 16 * fe); const u32x4 og0 = ogp[0], og1 = ogp[1];
            LDS_WAIT(); __syncthreads();
            { f32x16 oacc = {};
              for (int st = 0; st <= tt; ++st) { f32x16 sacc = {};
#pragma unroll
                  for (int kk = 0; kk < 8; ++kk) { const bf16x8 a = *(const LAS bf16x8*)(lds + L_KE + (32 * st + l31) * QP + (16 * kk + 8 * hh) * 2);
                      const bf16x8 bq = *(const LAS bf16x8*)(lds + L_QE + (32 * tt + l31) * QP + (16 * kk + 8 * hh) * 2);
                      sacc = __builtin_amdgcn_mfma_f32_32x32x16_bf16(a, bq, sacc, 0, 0, 0); }
                  if (st == tt) {
#pragma unroll
                      for (int r = 0; r < 16; ++r) { const int sl = (r & 3) + 8 * (r >> 2) + 4 * hh; if (sl > l31) sacc[r] = 0.f; } }
#pragma unroll
                  for (int s2 = 0; s2 < 2; ++s2) { u32x4 pw; pw.x = cvt_pk_bf16(sacc[8 * s2 + 0], sacc[8 * s2 + 1]); pw.y = cvt_pk_bf16(sacc[8 * s2 + 2], sacc[8 * s2 + 3]);
                      pw.z = cvt_pk_bf16(sacc[8 * s2 + 4], sacc[8 * s2 + 5]); pw.w = cvt_pk_bf16(sacc[8 * s2 + 6], sacc[8 * s2 + 7]);
                      const LAS unsigned char* vb = lds + L_VT + (32 * et + l31) * KP + (32 * st + 16 * s2 + 4 * hh) * 2;
                      const u32x2 lo = *(const LAS u32x2*)vb, hi = *(const LAS u32x2*)(vb + 16); const u32x4 vw = {lo.x, lo.y, hi.x, hi.y};
                      oacc = __builtin_amdgcn_mfma_f32_32x32x16_bf16(__builtin_bit_cast(bf16x8, vw), __builtin_bit_cast(bf16x8, pw), oacc, 0, 0, 0); } }
#pragma unroll
              for (int kt = 0; kt < 4; ++kt)
#pragma unroll
                  for (int s2 = 0; s2 < 2; ++s2) { u32x4 aw; aw.x = cvt_pk_bf16(S[kt][8 * s2 + 0], S[kt][8 * s2 + 1]); aw.y = cvt_pk_bf16(S[kt][8 * s2 + 2], S[kt][8 * s2 + 3]);
                      aw.z = cvt_pk_bf16(S[kt][8 * s2 + 4], S[kt][8 * s2 + 5]); aw.w = cvt_pk_bf16(S[kt][8 * s2 + 6], S[kt][8 * s2 + 7]);
                      const LAS unsigned char* qb = lds + L_QE + (32 * tt + l31) * QP + (32 * kt + 16 * s2 + 4 * hh) * 2;
                      const u32x2 lo = *(const LAS u32x2*)qb, hi = *(const LAS u32x2*)(qb + 16); const u32x4 bw = {lo.x, lo.y, hi.x, hi.y};
                      oacc = __builtin_amdgcn_mfma_f32_32x32x16_bf16(__builtin_bit_cast(bf16x8, aw), __builtin_bit_cast(bf16x8, bw), oacc, 0, 0, 0); }
#pragma unroll
              for (int kt = 0; kt < 4; ++kt) { f32x16 cacc;
#pragma unroll
                  for (int i = 0; i < 4; ++i) { const f32x4 dv = *(const LAS f32x4*)(lds + L_D + (32 * kt + 8 * i + 4 * hh) * 4);
#pragma unroll
                      for (int j = 0; j < 4; ++j) cacc[4 * i + j] = S[kt][4 * i + j] * dv[j]; }
#pragma unroll
                  for (int ss = 0; ss < 4; ++ss) { const bf16x8 a = *(const LAS bf16x8*)(lds + L_KD + (32 * kt + l31) * KP + (16 * ss + 8 * hh) * 2);
                      const bf16x8 bv = *(const LAS bf16x8*)(lds + L_VT + (32 * et + l31) * KP + (16 * ss + 8 * hh) * 2);
                      cacc = __builtin_amdgcn_mfma_f32_32x32x16_bf16(a, bv, cacc, 0, 0, 0); }
                  S[kt] = cacc; }
              float ssq = 0.f;
#pragma unroll
              for (int r = 0; r < 16; ++r) ssq += oacc[r] * oacc[r];
              ssq += __shfl_xor(ssq, 32);
              if (hh == 0) ((LAS float*)(lds + L_RED))[et * 64 + 32 * tt + l31] = ssq;
#pragma unroll
              for (int i = 0; i < 4; ++i) *(LAS f32x4*)(lds + L_O + (32 * tt + l31) * OP + (32 * et + 8 * i + 4 * hh) * 4) = (f32x4){oacc[4 * i], oacc[4 * i + 1], oacc[4 * i + 2], oacc[4 * i + 3]}; }
            LDS_WAIT(); __syncthreads();
            { const LAS float* red = (const LAS float*)(lds + L_RED); const float rinv = __builtin_amdgcn_rsqf(((red[ft] + red[64 + ft]) + (red[128 + ft] + red[192 + ft])) * (1.0f / HG_DK) + EPS);
              f32x4 ov[4];
#pragma unroll
              for (int i = 0; i < 4; ++i) ov[i] = *(const LAS f32x4*)(lds + L_O + ft * OP + (16 * fe + 4 * i) * 4) * rinv * *(const f32x4*)(gnorm + 16 * fe + 4 * i);
              f32x4 g0, g1, g2, g3; epi::unpack8(og0, g0, g1); epi::unpack8(og1, g2, g3);
              bf16_t* dst = OGATED + ((blk0 + c) * 64 + ft) * D + h * 128 + 16 * fe;
              *(u32x4*)dst = epi::pack8(ov[0] * g0, ov[1] * g1); *(u32x4*)(dst + 8) = epi::pack8(ov[2] * g2, ov[3] * g3); }
        }
#undef OP_LOAD
    }
}

__device__ __forceinline__ void attn_phase(Frame& F, const bf16_t* Q2, const bf16_t* K2, const bf16_t* VT2, const float* rel_bias, const float* sink, bf16_t* AO) {
    constexpr int KPT = 144, VPT = 400, L_KB = 0, L_VB = 192 * KPT, ABUF = L_VB + 64 * VPT, L_BT = 2 * ABUF, L_OST = L_BT + QH * WIN * 4, OPT = 144;
    static_assert(L_OST + 8 * 32 * OPT <= PHASE_LDS, "attention LDS");
    LAS unsigned char* lds = F.lds;
    LAS float* BT = (LAS float*)(lds + L_BT);
    const int tid = fresh_tid(), lane = tid & 63, w = __builtin_amdgcn_readfirstlane(tid >> 6), l31 = lane & 31, hh = lane >> 5;
    for (int idx = tid; idx < QH * WIN; idx += 512) { const int hq = idx >> 7, n = idx & 127; int bk;
        if (n < 16) bk = n; else { bk = 16 + (int)(__logf((float)n * (1.0f / 16.0f)) / __logf(8.0f) * 16.0f); bk = bk > 31 ? 31 : bk; }
        BT[idx] = rel_bias[bk * QH + hq] * LOG2E; }
    constexpr int NITEM = BATCH * KVH * (SEQ / 64);
    u32x4 rk[3], rvv[3]; bf16x8 qf[4];
#define AT_LOAD(it_) do { const int b_ = (it_) / (KVH * (SEQ / 64)), kvh_ = ((it_) / (SEQ / 64)) % KVH, pg_ = (it_) % (SEQ / 64); const size_t rowb_ = (size_t)b_ * SEQ; \
        _Pragma("unroll") for (int i_ = 0; i_ < 3; ++i_) { const int p_ = tid + 512 * i_, kr_ = 64 * pg_ - 128 + (p_ >> 3); \
            rk[i_] = kr_ >= 0 ? *(const u32x4*)(K2 + (rowb_ + kr_) * 256 + kvh_ * HD + (p_ & 7) * 8) : (u32x4){0u, 0u, 0u, 0u}; \
            const int blk_ = pg_ - 2 + i_; rvv[i_] = blk_ >= 0 ? *(const u32x4*)(VT2 + (((size_t)b_ * (SEQ / 64) + blk_) * 256 + kvh_ * HD + (tid >> 3)) * 64 + (tid & 7) * 8) : (u32x4){0u, 0u, 0u, 0u}; } } while (0)
#define AT_LOADQ(it_) do { const int b_ = (it_) / (KVH * (SEQ / 64)), kvh_ = ((it_) / (SEQ / 64)) % KVH, pg_ = (it_) % (SEQ / 64); const size_t rowb_ = (size_t)b_ * SEQ; \
        const int hq_ = 4 * kvh_ + (w & 3), p0_ = 64 * pg_ + 32 * (w >> 2); \
        _Pragma("unroll") for (int kk = 0; kk < 4; ++kk) qf[kk] = *(const bf16x8*)(Q2 + (rowb_ + p0_ + l31) * D + hq_ * HD + 16 * kk + 8 * hh); } while (0)
#define AT_WRITE(buf_) do { LAS unsigned char* s_ = lds + (buf_) * ABUF; \
        _Pragma("unroll") for (int i_ = 0; i_ < 3; ++i_) { const int p_ = tid + 512 * i_; *(LAS u32x4*)(s_ + L_KB + (p_ >> 3) * KPT + (p_ & 7) * 16) = rk[i_]; \
            *(LAS u32x4*)(s_ + L_VB + (tid >> 3) * VPT + i_ * 128 + (tid & 7) * 16) = rvv[i_]; } } while (0)
    int it = F.vcu, buf = 0;
    if (it < NITEM) { AT_LOAD(it); AT_LOADQ(it); AT_WRITE(0); }
    LDS_WAIT(); __syncthreads();
    for (; it < NITEM; it += F.G) {
        const int b = it / (KVH * (SEQ / 64)), kvh = (it / (SEQ / 64)) % KVH, pg = it % (SEQ / 64);
        const int hq = 4 * kvh + (w & 3), wq = w >> 2, p0 = 64 * pg + 32 * wq;
        const size_t rowb = (size_t)b * SEQ;
        const LAS unsigned char* sb = lds + buf * ABUF;
        const bool more = it + F.G < NITEM;
        f32x16 s[5];
        const int j0 = p0 >= 128 ? 0 : (128 - p0) / 32;
        const float zs = sink[hq] * LOG2E; float mx = zs;
        int ib = l31 - 4 * hh; asm volatile("" : "+v"(ib));
        const LAS float* bp = BT + hq * WIN + (ib - 31);
#pragma unroll
        for (int j = 0; j < 5; ++j) {
#pragma unroll
            for (int r = 0; r < 16; ++r) s[j][r] = bp[128 - 32 * j - ((r & 3) + 8 * (r >> 2)) + 31];
#pragma unroll
            for (int kk = 0; kk < 4; ++kk) { const bf16x8 kf = *(const LAS bf16x8*)(sb + L_KB + (32 * wq + 32 * j + l31) * KPT + (16 * kk + 8 * hh) * 2);
                s[j] = __builtin_amdgcn_mfma_f32_32x32x16_bf16(kf, qf[kk], s[j], 0, 0, 0); } }
        if (more) { AT_LOADQ(it + F.G); AT_LOAD(it + F.G); }
#pragma unroll
        for (int j = 0; j < 5; ++j) { const bool jin = j >= j0;
#pragma unroll
            for (int r = 0; r < 16; ++r) { const int cr = (r & 3) + 8 * (r >> 2);
                const bool ok = jin && (j == 0 ? ib < cr : (j == 4 ? ib >= cr : true));
                const float z = ok ? s[j][r] : -INFINITY; s[j][r] = z; mx = fmaxf(mx, z); } }
        mx = fmaxf(mx, __shfl_xor(mx, 32));
        float den = 0.f;
#pragma unroll
        for (int j = 0; j < 5; ++j)
#pragma unroll
            for (int r = 0; r < 16; ++r) { const float p = __builtin_amdgcn_exp2f(s[j][r] - mx); s[j][r] = p; den += p; }
        den += __shfl_xor(den, 32); den += __builtin_amdgcn_exp2f(zs - mx);
        const float inv = fast_rcp(den);
        f32x16 o[2]; o[0] = (f32x16){}; o[1] = (f32x16){};
#pragma unroll
        for (int j = 0; j < 5; ++j) { {
#pragma unroll
            for (int s2 = 0; s2 < 2; ++s2) { u32x4 pw; pw.x = cvt_pk_bf16(s[j][8 * s2 + 0], s[j][8 * s2 + 1]); pw.y = cvt_pk_bf16(s[j][8 * s2 + 2], s[j][8 * s2 + 3]);
                pw.z = cvt_pk_bf16(s[j][8 * s2 + 4], s[j][8 * s2 + 5]); pw.w = cvt_pk_bf16(s[j][8 * s2 + 6], s[j][8 * s2 + 7]);
#pragma unroll
                for (int dt = 0; dt < 2; ++dt) { const LAS unsigned char* vp = sb + L_VB + (32 * dt + l31) * VPT + (32 * wq + 32 * j + 16 * s2 + 4 * hh) * 2;
                    const u32x2 lo = *(const LAS u32x2*)vp, hi = *(const LAS u32x2*)(vp + 16); const u32x4 vw = {lo.x, lo.y, hi.x, hi.y};
                    o[dt] = __builtin_amdgcn_mfma_f32_32x32x16_bf16(__builtin_bit_cast(bf16x8, vw), __builtin_bit_cast(bf16x8, pw), o[dt], 0, 0, 0); } } } }
        { LAS unsigned char* ost = lds + L_OST + w * (32 * OPT);
#pragma unroll
          for (int dt = 0; dt < 2; ++dt)
#pragma unroll
              for (int i = 0; i < 4; ++i) { u32x2 wv; wv.x = cvt_pk_bf16(o[dt][4 * i] * inv, o[dt][4 * i + 1] * inv); wv.y = cvt_pk_bf16(o[dt][4 * i + 2] * inv, o[dt][4 * i + 3] * inv);
                  *(LAS u32x2*)(ost + l31 * OPT + (32 * dt + 8 * i + 4 * hh) * 2) = wv; }
          LDS_WAIT();
          bf16_t* obase = AO + (rowb + p0) * D + hq * HD + (lane & 7) * 8;
#pragma unroll
          for (int k = 0; k < 4; ++k) { const int row = (lane >> 3) + 8 * k; const u32x4 v = *(const LAS u32x4*)(ost + row * OPT + (lane & 7) * 16); *(u32x4*)(obase + (size_t)row * D) = v; } }
        if (more) AT_WRITE(buf ^ 1);
        LDS_WAIT(); __syncthreads();
        buf ^= 1;
    }
#undef AT_LOAD
#undef AT_LOADQ
#undef AT_WRITE
}

__device__ __forceinline__ void router_phase(Frame& F, const bf16_t* H3, const u64* rowss, const float* router, const float* gain, gu32* ctl, int* LTOK, float* LG) {
    LAS float* WRG = (LAS float*)F.lds;
    LAS int* SEL = (LAS int*)(F.lds + 32768);
    LAS float* GATE = (LAS float*)(F.lds + 32768 + 1024);
    LAS int* RANK = (LAS int*)(F.lds + 32768 + 3072);
    LAS unsigned* CNT = (LAS unsigned*)(F.lds + 32768 + 5120);
    const int tid = fresh_tid(), lane = tid & 63, w = __builtin_amdgcn_readfirstlane(tid >> 6);
#pragma unroll
    for (int i = 0; i < 4; ++i) { const int q = tid + 512 * i; const f32x4 rv = ((const f32x4*)router)[q]; ((LAS f32x4*)WRG)[q] = rv * gain[q >> 1]; }
    for (int tb = F.vcu; tb < T / 256; tb += F.G) {
        if (tid < 32) CNT[tid] = 0u;
        LDS_WAIT(); __syncthreads();
        unsigned xn[4][8];
#define RT_LOAD(q4_) do { const size_t t0_ = (size_t)tb * 256 + w * 32 + 4 * (q4_); \
            _Pragma("unroll") for (int t = 0; t < 4; ++t) { const unsigned* xr = (const unsigned*)(H3 + (t0_ + t) * D) + lane; _Pragma("unroll") for (int m = 0; m < 8; ++m) xn[t][m] = xr[64 * m]; } } while (0)
        RT_LOAD(0);
#pragma unroll 1
        for (int q4 = 0; q4 < 8; ++q4) {
            const int tl0 = w * 32 + 4 * q4; const size_t tok0 = (size_t)tb * 256 + tl0;
            unsigned xw[4][8];
#pragma unroll
            for (int t = 0; t < 4; ++t)
#pragma unroll
                for (int m = 0; m < 8; ++m) xw[t][m] = xn[t][m];
            if (q4 + 1 < 8) RT_LOAD(q4 + 1);
            float acc[4][8];
#pragma unroll
            for (int t = 0; t < 4; ++t)
#pragma unroll
                for (int e = 0; e < 8; ++e) acc[t][e] = 0.f;
#pragma unroll
            for (int m = 0; m < 8; ++m) { const LAS f32x4* wp = (const LAS f32x4*)(WRG + (2 * lane + 128 * m) * 8); const f32x4 w0 = wp[0], w1 = wp[1], w2 = wp[2], w3 = wp[3];
#pragma unroll
                for (int t = 0; t < 4; ++t) { const float x0 = bf_lo(xw[t][m]), x1 = bf_hi(xw[t][m]);
#pragma unroll
                    for (int e = 0; e < 4; ++e) { fmac_s(acc[t][e], x0, w0[e]); fmac_s(acc[t][e], x1, w2[e]); fmac_s(acc[t][4 + e], x0, w1[e]); fmac_s(acc[t][4 + e], x1, w3[e]); } }
                if (m & 1) asm volatile("" ::: "memory"); }
#pragma unroll
            for (int o = 1; o < 64; o <<= 1) {
#pragma unroll
                for (int t = 0; t < 4; ++t) {
#pragma unroll
                    for (int e = 0; e < 8; ++e) acc[t][e] += __shfl_xor(acc[t][e], o); } }
#pragma unroll
            for (int t = 0; t < 4; ++t) { const int tl = tl0 + t;
                const float r = rinv_of(rowss[tok0 + t]);
                int e1 = 0; float l1 = acc[t][0];
#pragma unroll
                for (int e = 1; e < 8; ++e) if (acc[t][e] > l1) { l1 = acc[t][e]; e1 = e; }
                int e2 = e1 == 0 ? 1 : 0; float l2 = -INFINITY;
#pragma unroll
                for (int e = 0; e < 8; ++e) if (e != e1 && acc[t][e] > l2) { l2 = acc[t][e]; e2 = e; }
                const float g2 = 1.0f / (1.0f + __expf((l1 - l2) * r)), g1 = 1.0f - g2;
                if (lane == 0) { SEL[tl] = e1 | (e2 << 8); GATE[2 * tl] = g1; GATE[2 * tl + 1] = g2; } } }
        LDS_WAIT(); __syncthreads();
        int e1 = 0, e2 = 0;
        if (tid < 256) { const int sv = SEL[tid]; e1 = sv & 255; e2 = sv >> 8; RANK[2 * tid] = (int)__hip_atomic_fetch_add(&CNT[e1], 1u, __ATOMIC_RELAXED, __HIP_MEMORY_SCOPE_WORKGROUP); RANK[2 * tid + 1] = (int)__hip_atomic_fetch_add(&CNT[8 + e2], 1u, __ATOMIC_RELAXED, __HIP_MEMORY_SCOPE_WORKGROUP); }
        LDS_WAIT(); __syncthreads();
        if (tid < 16) CNT[16 + tid] = __hip_atomic_fetch_add(ctl + CW_MCNT + 64 * tid, CNT[tid], RLX_AGENT);
        LDS_WAIT(); __syncthreads();
        if (tid < 256) { const int tok = tb * 256 + tid; const unsigned p1 = CNT[16 + e1] + (unsigned)RANK[2 * tid], p2 = CNT[24 + e2] + (unsigned)RANK[2 * tid + 1];
            LTOK[(size_t)e1 * T + p1] = tok; LG[(size_t)e1 * T + p1] = GATE[2 * tid];
            LTOK[(size_t)(8 + e2) * T + p2] = tok; LG[(size_t)(8 + e2) * T + p2] = GATE[2 * tid + 1]; }
        __syncthreads();
    }
}
__device__ __forceinline__ unsigned moe_counts(const gu32* ctl) {
    const int l = (int)__builtin_amdgcn_mbcnt_hi(~0u, __builtin_amdgcn_mbcnt_lo(~0u, 0u)) & 15;
    return ld_agent((const unsigned*)ctl + CW_MCNT + 64 * l);
}
__device__ __forceinline__ void moe_tiles(const gu32* ctl, int k, int* tstart  , unsigned* cnt = nullptr) {
    const unsigned cv = moe_counts(ctl); int a = 0;
#pragma unroll
    for (int e = 0; e < NE; ++e) { tstart[e] = a; const unsigned c = (unsigned)__builtin_amdgcn_readlane((int)cv, k * 8 + e); if (cnt) cnt[e] = c; a += (int)((c + 255u) >> 8); }
    tstart[NE] = a;
}
__device__ __forceinline__ void rowtable_phase(Frame& F, const gu32* ctl, const int* LTOK, const float* LG, const u64* rowss, int* RTOK, float* RG, float* RRINV, int* TILEE) {
    for (int k = 0; k < 2; ++k) { int ts[9]; unsigned cnt[8]; moe_tiles(ctl, k, ts, cnt);
        const int nrows = ts[NE] * 256;
        for (int pr = F.vcu * 512 + fresh_tid(); pr < nrows; pr += F.G * 512) { const int rt = pr >> 8; int e = 0; int st = 0; unsigned ce = cnt[0];
#pragma unroll
            for (int ee = 1; ee < NE; ++ee) if (rt >= ts[ee]) { e = ee; st = ts[ee]; ce = cnt[ee]; }
            const unsigned pos = (unsigned)(pr - st * 256); int tok = -1; float gt = 0.f, ri = 0.f;
            if (pos < ce) { tok = LTOK[(size_t)(k * 8 + e) * T + pos]; gt = LG[(size_t)(k * 8 + e) * T + pos]; ri = rinv_of(rowss[tok]) * (1.0f / (S8_H3 * S8_WGU)); gt *= 1.0f / (S8_HID * S8_WDN); }
            RTOK[k * MPAD + pr] = tok; RG[k * MPAD + pr] = gt; RRINV[k * MPAD + pr] = ri;
            if ((pr & 255) == 0) TILEE[k * 512 + rt] = e; } }
}

struct Args { Ptrs p; int ph_lo, ph_hi; };
#ifndef DBG_STAGE
#define DBG_STAGE 99
#endif
__global__ void __launch_bounds__(512, 2) fwd_kernel(Args args) {
    extern __shared__ __attribute__((aligned(16))) unsigned char lds_raw[];
    Frame F;
    F.lds = (LAS unsigned char*)lds_raw;
    F.tid = threadIdx.x; F.lane = F.tid & 63; F.wave = __builtin_amdgcn_readfirstlane(F.tid >> 6);
    F.G = gridDim.x; { const int bx = blockIdx.x; F.vcu = (F.G % 8 == 0) ? (bx % 8) * (F.G / 8) + bx / 8 : bx; }
    const Ptrs& P = args.p;
    unsigned char* ws = P.ws;
    gu32* ctl = (gu32*)(ws + WS_CTL);
    volatile LAS unsigned* MISC = (volatile LAS unsigned*)(F.lds + MISC_OFF);
    for (int u = F.tid; u < (LDS_BYTES - PHASE_LDS) / 4; u += 512) ((LAS unsigned*)(F.lds + PHASE_LDS))[u] = 0u;
    __syncthreads();
    XcdBarrier bar = xcd_barrier_post((unsigned*)(ctl + CW_BAR), MISC + 8);
    const int lo = args.ph_lo, hi = args.ph_hi;
#define IN(k) (lo <= (k) && (k) < hi)
#ifndef PROBE_SEAM
#define PROBE_SEAM -1
#endif
    volatile LAS unsigned long long* PRB = (volatile LAS unsigned long long*)(F.lds + MISC_OFF + 64);
    if (PROBE_SEAM >= 0 && fresh_tid() == 0) PRB[0] = __builtin_amdgcn_s_memrealtime();
#define SEAM(k) do { if (IN(k) && IN((k) + 1)) xcd_barrier(bar); if (PROBE_SEAM == (k) && fresh_tid() == 0) PRB[1] = __builtin_amdgcn_s_memrealtime(); } while (0)
    using namespace pg8;
    const int bid = (int)blockIdx.x;
    u64* rowss1 = (u64*)(ws + WS_ROWSS1); u64* rowss2 = (u64*)(ws + WS_ROWSS2); u64* rowss3 = (u64*)(ws + WS_ROWSS3);

    if (IN(0)) { p0_prologue(F, P); } SEAM(0);
    if (IN(1)) { Gemm g{(const bf16_t*)(ws + WS_XN), (const bf16_t*)(ws + WS_WQO), D, 0, nullptr}; StaticOrder S; S.init(T / 256, 4, F.G, bid);
        epi::EpiOG E{(bf16_t*)(ws + WS_OG1)}; gemm_phase<epi::EpiOG, StaticOrder, false>(F.lds, g, S, E, F.wave); }
    if (IN(2)) { Gemm g{(const bf16_t*)(ws + WS_WFI), (const bf16_t*)(ws + WS_XN), D, 0, nullptr}; StaticOrder S; S.init(12, T / 256, F.G, bid);
        static_assert(WS_GT == WS_Q1 + 128 * MiB && WS_VT == WS_GT + 128 * MiB, "QT|GT|VT spacing");
        epi::EpiQFI E{(unsigned short*)(ws + WS_Q1), (const float*)(ws + WS_LB)}; gemm_phase<epi::EpiQFI, StaticOrder, false>(F.lds, g, S, E, F.wave); }
    SEAM(2);
    if (IN(3)) scan_state_pass(F, (const unsigned short*)(ws + WS_GT), (const bf16_t*)(ws + WS_VT), (float*)(ws + WS_SST));
    SEAM(3);
    if (IN(4)) scan_output_pass(F, (const bf16_t*)(ws + WS_Q1), (const unsigned short*)(ws + WS_GT), (const bf16_t*)(ws + WS_VT), (const float*)(ws + WS_SST), (const bf16_t*)(ws + WS_OG1), P.gnorm, (bf16_t*)(ws + WS_OGATED));
    SEAM(4);
    if (IN(5)) { Gemm g{(const bf16_t*)(ws + WS_OGATED), (const bf16_t*)(ws + WS_WOUT), D, 0, nullptr}; StaticOrder S; S.init(T / 256, 4, F.G, bid);
        epi::EpiRes<2, DBG_STAGE == 1> E{(const void*)(ws + WS_XN), (bf16_t*)(ws + WS_H1), P.out, rowss1, nullptr, (const float*)(ws + WS_INVR0), (const float*)(ws + WS_INVG)}; gemm_phase<epi::EpiRes<2, DBG_STAGE == 1>, StaticOrder, false>(F.lds, g, S, E, F.wave); }
    SEAM(5);
#if DBG_STAGE >= 2
    if (IN(6)) { Gemm g{(const bf16_t*)(ws + WS_H1), (const bf16_t*)(ws + WS_WGU), D, 0, nullptr}; StaticOrder S; S.init(T / 256, 2 * FF0 / 256, F.G, bid);
        epi::EpiGU<false> E{(bf16_t*)(ws + WS_HID0), FF0, rowss1}; gemm_phase<epi::EpiGU<false>, StaticOrder, false>(F.lds, g, S, E, F.wave); }
    SEAM(6);
    if (IN(7)) { Gemm g{(const bf16_t*)(ws + WS_HID0), (const bf16_t*)(ws + WS_WDN), FF0, 0, nullptr}; StaticOrder S; S.init(T / 256, 4, F.G, bid);
        epi::EpiRes<0, DBG_STAGE == 2> E{(const void*)(ws + WS_H1), (bf16_t*)(ws + WS_H2), P.out, rowss2, nullptr, nullptr, nullptr}; gemm_phase<epi::EpiRes<0, DBG_STAGE == 2>, StaticOrder, false>(F.lds, g, S, E, F.wave); }
    SEAM(7);
#endif
#if DBG_STAGE >= 3
    if (IN(8)) { { Gemm g{(const bf16_t*)(ws + WS_H2), (const bf16_t*)(ws + WS_WQK), D, 0, nullptr}; StaticOrder S; S.init(T / 256, 5, F.G, bid);
          epi::EpiQK E{(bf16_t*)(ws + WS_Q2), (bf16_t*)(ws + WS_K2), rowss2, P.q_gain, P.k_gain}; gemm_phase<epi::EpiQK, StaticOrder, false>(F.lds, g, S, E, F.wave); }
        { Gemm g{(const bf16_t*)(ws + WS_WV), (const bf16_t*)(ws + WS_H2), D, 0, nullptr}; StaticOrder S; S.init(1, T / 256, F.G, bid);
          epi::EpiVT E{(bf16_t*)(ws + WS_VT2), rowss2}; gemm_phase<epi::EpiVT, StaticOrder, false>(F.lds, g, S, E, F.wave); } }
    SEAM(8);
    if (IN(9)) attn_phase(F, (const bf16_t*)(ws + WS_Q2), (const bf16_t*)(ws + WS_K2), (const bf16_t*)(ws + WS_VT2), P.rel_bias, P.sink, (bf16_t*)(ws + WS_AO));
    SEAM(9);
    if (IN(10)) { Gemm g{(const bf16_t*)(ws + WS_AO), (const bf16_t*)(ws + WS_WO), D, 0, nullptr}; StaticOrder S; S.init(T / 256, 4, F.G, bid);
        epi::EpiRes<0, false, true> E{(const void*)(ws + WS_H2), (bf16_t*)(ws + WS_H2), nullptr, rowss3, ws + WS_H38, nullptr, nullptr}; gemm_phase<epi::EpiRes<0, false, true>, StaticOrder, false>(F.lds, g, S, E, F.wave); }
    SEAM(10);
#endif
#if DBG_STAGE >= 4
    if (IN(11)) router_phase(F, (const bf16_t*)(ws + WS_H2), rowss3, P.router, P.ffn_norm + D, ctl, (int*)(ws + WS_LTOK), (float*)(ws + WS_LG));
    SEAM(11);
    if (IN(12)) rowtable_phase(F, ctl, (const int*)(ws + WS_LTOK), (const float*)(ws + WS_LG), rowss3, (int*)(ws + WS_RTOK), (float*)(ws + WS_RG), (float*)(ws + WS_RRINV), (int*)(ws + WS_TILEE));
    SEAM(12);
#pragma unroll
    for (int k = 0; k < 2; ++k) {
        if (IN(13 + 2 * k)) { int ts[9]; moe_tiles(ctl, k, ts);
            Gemm g{(const bf16_t*)(ws + WS_H38), (const bf16_t*)(ws + WS_MGU), D, (size_t)2 * FFE * D, (const int*)(ws + WS_RTOK) + k * MPAD};   StaticOrder S; S.init(ts[NE], 2 * FFE / 256, F.G, k == 0 ? bid : F.G - 1 - bid  , ts);
            epi::EpiGU<true> E{(bf16_t*)(ws + WS_HIDM + (size_t)k * MPAD * FFE), FFE, (const float*)(ws + WS_RRINV) + k * MPAD}; gemm_phase<epi::EpiGU<true>, StaticOrder, true, true>(F.lds, g, S, E, F.wave); }
        SEAM(13 + 2 * k);
        if (IN(14 + 2 * k)) { int ts[9]; moe_tiles(ctl, k, ts);
            Gemm g{(const bf16_t*)(ws + WS_HIDM + (size_t)k * MPAD * FFE), (const bf16_t*)(ws + WS_MDN), FFE, (size_t)D * FFE, nullptr}; StaticOrder S; S.init(ts[NE], 4, F.G, bid, ts);
            if (k == 0) { epi::EpiMoeDown<true> E{P.out, (const int*)(ws + WS_RTOK), (const float*)(ws + WS_RG), (bf16_t*)(ws + WS_H2), ws + WS_TILEE + 65536}; gemm_phase<epi::EpiMoeDown<true>, StaticOrder, false, true>(F.lds, g, S, E, F.wave); }
            else { epi::EpiMoeDown<false> E{P.out, (const int*)(ws + WS_RTOK) + MPAD, (const float*)(ws + WS_RG) + MPAD, (bf16_t*)(ws + WS_H2), ws + WS_TILEE + 65536}; gemm_phase<epi::EpiMoeDown<false>, StaticOrder, false, true>(F.lds, g, S, E, F.wave); } }
        if (k == 1) SEAM(14 + 2 * k);
    }
#endif
    if (PROBE_SEAM >= 0 && blockIdx.x == 0 && fresh_tid() == 0) { const unsigned long long tend = __builtin_amdgcn_s_memrealtime(), want = 8ull * (PRB[1] - PRB[0]);
        while (__builtin_amdgcn_s_memrealtime() - tend < want) __builtin_amdgcn_s_sleep(32); }
#undef IN
#undef SEAM
}
constexpr int N_PHASES = 17;

extern "C" void kernel_launch(void* const* d_in, const int* in_sizes, int n_in, void* d_out, int out_size, void* d_ws, size_t ws_size, hipStream_t stream) {
    static int grid = 0;
    if (grid == 0) {
        if (n_in != 22 || in_sizes[0] != T * D || out_size != T * D || ws_size < WS_END) { fprintf(stderr, "kernel_launch: unexpected shapes/workspace: n_in %d in0 %d out %d ws %zu (need %zu)\n", n_in, n_in > 0 ? in_sizes[0] : -1, out_size, ws_size, (size_t)WS_END); grid = -1; return; }
        int dev = 0, cus = 0, per_cu = 0;
        if (hipGetDevice(&dev) != hipSuccess || hipDeviceGetAttribute(&cus, hipDeviceAttributeMultiprocessorCount, dev) != hipSuccess) { fprintf(stderr, "kernel_launch: device query failed\n"); grid = -1; return; }
        if (hipFuncSetAttribute((const void*)fwd_kernel, hipFuncAttributeMaxDynamicSharedMemorySize, LDS_BYTES) != hipSuccess) { fprintf(stderr, "kernel_launch: hipFuncSetAttribute failed\n"); grid = -1; return; }
        if (hipOccupancyMaxActiveBlocksPerMultiprocessor(&per_cu, (const void*)fwd_kernel, 512, LDS_BYTES) != hipSuccess || per_cu < 1) fprintf(stderr, "kernel_launch: occupancy query reports %d blocks per CU\n", per_cu);
        (void)hipGetLastError();
        grid = cus;
    }
    if (grid < 0) return;
    if (hipMemsetAsync((char*)d_ws + WS_CTL, 0, CTL_ZERO_BYTES, stream) != hipSuccess) { fprintf(stderr, "kernel_launch: memset failed\n"); return; }
    Args a{};
    const float** pp = (const float**)&a.p;
    for (int i = 0; i < 22; ++i) pp[i] = (const float*)d_in[i];
    a.p.out = (float*)d_out; a.p.ws = (unsigned char*)d_ws;
    a.ph_lo = 0; a.ph_hi = N_PHASES;
    hipLaunchKernelGGL(fwd_kernel, dim3(grid), dim3(512), LDS_BYTES, stream, a);
    const hipError_t le = hipPeekAtLastError();
    if (le != hipSuccess) fprintf(stderr, "kernel_launch: launch failed: %s\n", hipGetErrorName(le));
}
```

```cpp
#include <hip/hip_runtime.h>
#include <cstdio>
#include <cstdint>

#define LAS __attribute__((address_space(3)))
#define GAS __attribute__((address_space(1)))
typedef unsigned short bf16_t;
typedef short bf16x8 __attribute__((ext_vector_type(8)));
typedef short s16x4 __attribute__((ext_vector_type(4)));
typedef float f32x4 __attribute__((ext_vector_type(4)));
typedef float f32x2 __attribute__((ext_vector_type(2)));
typedef float f32x16 __attribute__((ext_vector_type(16)));
typedef unsigned u32x4 __attribute__((ext_vector_type(4)));
typedef unsigned u32x2 __attribute__((ext_vector_type(2)));
typedef _Float16 f16x2 __attribute__((ext_vector_type(2)));
typedef GAS unsigned gu32;
typedef int i32x4 __attribute__((ext_vector_type(4)));
typedef int i32x8 __attribute__((ext_vector_type(8)));

constexpr int BATCH = 8, SEQ = 8192, D = 1024, T = BATCH * SEQ;
constexpr int HG_H = 8, HG_DK = 128, CHK = 64, NCHK = SEQ / CHK;
constexpr int FF0 = 2816, NE = 8, FFE = 3584;
constexpr int QH = 16, KVH = 4, HD = 64, WIN = 128;
constexpr float EPS = 1e-6f;
constexpr float LOG2E = 1.4426950408889634f;
constexpr float S8_H3 = 8.0f, S8_WGU = 64.0f, S8_HID = 8.0f, S8_WDN = 128.0f;
#ifndef WO_FP8
#define WO_FP8 1
#endif
constexpr float S8_AO = 8.0f, S8_WO = 64.0f;
#ifndef FFN_GU_FP8
#define FFN_GU_FP8 1
#endif
#ifndef QKV_FP8
#define QKV_FP8 1
#endif
constexpr float S8_H2 = 8.0f, S8_WQ = 64.0f;
#ifndef FFN_DOWN_FP8
#define FFN_DOWN_FP8 1
#endif
constexpr int MPAD = T + NE * 256;
constexpr int MAXRT = MPAD / 256;

constexpr size_t MiB = 1u << 20;
constexpr size_t WS_CTL = 0, CTL_ZERO_BYTES = 4 * MiB;
constexpr size_t WS_ROWSS1 = 1 * MiB, WS_ROWSS2 = WS_ROWSS1 + 512 * 1024, WS_ROWSS3 = WS_ROWSS2 + 512 * 1024;
constexpr size_t WS_LB = 4 * MiB;
constexpr size_t WS_INVG = 4 * MiB + 8192, WS_INVR0 = 4 * MiB + 65536;
constexpr size_t WS_DCH = 5 * MiB;
constexpr size_t WS_LTOK = 9 * MiB, WS_LG = 13 * MiB;
constexpr size_t WS_RTOK = 17 * MiB, WS_RG = 18 * MiB, WS_RRINV = 19 * MiB, WS_TILEE = 20 * MiB;
constexpr size_t WS_WQO = 24 * MiB  , WS_WFI = 26 * MiB  , WS_WOUT = 32 * MiB, WS_WGU = 34 * MiB, WS_WDN = 45 * MiB, WS_WQK = 51 * MiB, WS_WV = 54 * MiB, WS_WO = 55 * MiB;
constexpr size_t WS_MGU = 57 * MiB, WS_MDN = 169 * MiB;
constexpr size_t WS_R0 = 226 * MiB, WS_R1 = 354 * MiB, WS_R2 = 482 * MiB, WS_R3 = 866 * MiB, WS_END = 994 * MiB;
constexpr size_t WS_XN = WS_R0, WS_H2 = WS_R0;
constexpr size_t WS_Q1 = WS_R1, WS_H1 = WS_R1, WS_AO = WS_R1, WS_HIDM = WS_R1;
constexpr size_t WS_GT = WS_R2, WS_VT = WS_R2 + 128 * MiB, WS_OG1 = WS_R2 + 256 * MiB, WS_HID0 = WS_R2;
constexpr size_t WS_OGATED = WS_OG1;
constexpr size_t WS_Q2 = WS_R2, WS_K2 = WS_R2 + 128 * MiB, WS_VT2 = WS_R2 + 160 * MiB;
constexpr size_t WS_H38 = WS_R3;
constexpr size_t WS_H28 = WS_R3;
constexpr size_t WS_H18 = WS_R3;
constexpr size_t WS_SST = WS_R3;
static_assert(WS_HIDM + (size_t)2 * MPAD * FFE <= WS_R3, "two fp8 hid buffers fit below H38");
static_assert(WS_HID0 + (size_t)T * FF0 * 2 <= WS_R3, "HID0 fits");
constexpr int CW_BAR = 4096;
constexpr int CW_MCNT = 16384;

constexpr int RING_BYTES = 131072;
constexpr int LDS_BYTES = 163840;
constexpr int PHASE_LDS = LDS_BYTES - 1024;
constexpr int MISC_OFF = PHASE_LDS + 320;

#define LDS_WAIT() asm volatile("s_waitcnt lgkmcnt(0)" ::: "memory")
#define VM_WAIT() asm volatile("s_waitcnt vmcnt(0)" ::: "memory")
#define RLX_AGENT __ATOMIC_RELAXED, __HIP_MEMORY_SCOPE_AGENT

__device__ __forceinline__ unsigned f2bf(float f) { unsigned u = __builtin_bit_cast(unsigned, f); return (u + 0x7fffu + ((u >> 16) & 1u)) >> 16; }
__device__ __forceinline__ unsigned pk2(float lo, float hi) { return f2bf(lo) | (f2bf(hi) << 16); }
__device__ __forceinline__ unsigned cvt_pk_bf16(float lo, float hi) { unsigned r; asm volatile("v_cvt_pk_bf16_f32 %0, %1, %2" : "=v"(r) : "v"(lo), "v"(hi)); return r; }
typedef float f32x2n __attribute__((ext_vector_type(2)));
typedef __bf16 bf16x2n __attribute__((ext_vector_type(2)));
__device__ __forceinline__ unsigned cvt_pk_bf16_n(float lo, float hi) { const f32x2n v = {lo, hi}; return __builtin_bit_cast(unsigned, __builtin_convertvector(v, bf16x2n)); }
__device__ __forceinline__ float bf_lo(unsigned w) { return __builtin_bit_cast(float, w << 16); }
__device__ __forceinline__ float bf_hi(unsigned w) { return __builtin_bit_cast(float, w & 0xffff0000u); }
__device__ __forceinline__ float bf1(bf16_t h) { return __builtin_bit_cast(float, (unsigned)h << 16); }
__device__ __forceinline__ unsigned pk_f16(float lo, float hi) { f16x2 v = {(_Float16)lo, (_Float16)hi}; return __builtin_bit_cast(unsigned, v); }
__device__ __forceinline__ unsigned pk4_fp8(float a, float b, float c, float d) { unsigned r = 0u; r = (unsigned)__builtin_amdgcn_cvt_pk_fp8_f32(a, b, (int)r, false); r = (unsigned)__builtin_amdgcn_cvt_pk_fp8_f32(c, d, (int)r, true); return r; }
__device__ __forceinline__ float clamp8(float v) { return __builtin_amdgcn_fmed3f(v, -440.0f, 440.0f); }
__device__ __forceinline__ float fast_exp(float x) { return __builtin_amdgcn_exp2f(x * LOG2E); }
__device__ __forceinline__ void fmac_s(float& acc, float a, float b) { asm("v_fmac_f32_e32 %0, %1, %2" : "+v"(acc) : "v"(a), "v"(b)); }
__device__ __forceinline__ float fast_rcp(float x) { return __builtin_amdgcn_rcpf(x); }
__device__ __forceinline__ float silu_f(float v) { return v * fast_rcp(1.0f + fast_exp(-v)); }
__device__ __forceinline__ int fresh_tid_w(int wave) { int t = wave * 64 + (int)__builtin_amdgcn_mbcnt_hi(~0u, __builtin_amdgcn_mbcnt_lo(~0u, 0u)); asm volatile("" : "+v"(t)); return t; }
#define fresh_tid() fresh_tid_w(F.wave)
__device__ __forceinline__ unsigned ld_agent(const unsigned* p) { return __hip_atomic_load((unsigned*)p, RLX_AGENT); }
typedef unsigned long long u64;
constexpr float SS_FIX = 1048576.0f;
__device__ __forceinline__ float rinv_of(u64 ssfix) { return __builtin_amdgcn_rsqf((float)ssfix * (1.0f / (SS_FIX * D)) + EPS); }

namespace pg8 {
constexpr int BM = 256, BK = 64, HALF = 128, HTB = HALF * BK * 2, STAGE_BYTES = 8 * HTB, NXCD = 8, WGM = 8;
__host__ __device__ __forceinline__ int lds_byte(int r, int c) { const int st = (r >> 4) * 2 + (c >> 5), rr = r & 15, cc = c & 31, ob = rr * 64 + cc * 2; return st * 1024 + (ob ^ (((ob >> 9) & 1) << 5)); }
__host__ __device__ __forceinline__ void stage_rc(int b, int& R, int& C) { const int st = b / 1024, sb = b % 1024, swz = sb ^ (((sb >> 9) & 1) << 5); R = (st >> 1) * 16 + swz / 64; C = (st & 1) * 32 + (swz % 64) / 2; }
__host__ __device__ __forceinline__ int perm32(int rho) { const int n = rho >> 4, i = rho & 15; return 8 * (i >> 2) + 4 * n + (i & 3); }

struct Unit { int pm, pn, e; };
struct Gemm { const bf16_t* A; const bf16_t* Bt; int K; size_t bstride  ; const int* rowtok  ; };

struct StaticOrder {
    int nM, nN, nwg, G, c; bool tiled; int ts[8];
    __device__ void init(int nM_, int nN_, int G_, int c_, const int* tstart = nullptr) { nM = nM_; nN = nN_; nwg = nM * nN; G = G_; c = c_; tiled = tstart != nullptr;
#pragma unroll
        for (int e = 0; e < 8; ++e) ts[e] = tstart ? tstart[e] : 0; }
    __device__ bool next(int i, Unit& u) const {
        const long L = (long)i * G + c; if (L >= nwg) return false;
        int wgid = (int)L; { const int q = nwg / NXCD, r = nwg % NXCD, xcd = wgid % NXCD, off = wgid / NXCD; wgid = (xcd < r ? xcd * (q + 1) : r * (q + 1) + (xcd - r) * q) + off; }
        const int nig = WGM * nN, gid = wgid / nig, fm = gid * WGM, gsz = (nM - fm) < WGM ? (nM - fm) : WGM;
        u.pm = fm + ((wgid % nig) % gsz); u.pn = (wgid % nig) / gsz;
        int e_ = 0;
        if (tiled) {
#pragma unroll
            for (int e = 1; e < 8; ++e) e_ += (u.pm >= ts[e]) ? 1 : 0; }
        u.e = e_;
        return true;
    }
};

template <class Epi, class Sched, bool GATHER, bool FP8 = false>
__device__ __forceinline__ void gemm_phase(LAS unsigned char* lds, const Gemm g, const Sched& S, const Epi& E, int wave_sgpr) {
    const int tid = fresh_tid_w(wave_sgpr), wid = __builtin_amdgcn_readfirstlane(tid >> 6), lane = tid & 63, wr = wid >> 2, wc = wid & 3, fr = lane & 15, fq = lane >> 4;
    const int K = g.K, RB = FP8 ? K : 2 * K  , nt = RB / (BK * 2);
    unsigned voffA[2], voffB[2]; int RA[2], CA[2];
#pragma unroll
    for (int i = 0; i < 2; ++i) { int R, C; stage_rc(tid * 16 + i * 8192, R, C); const int Rb = (R & ~31) + perm32(R & 31);
        RA[i] = R; CA[i] = C; voffA[i] = (unsigned)(R * RB + C * 2); voffB[i] = (unsigned)(Rb * RB + C * 2); }
    const size_t kstep = (size_t)(BK * 2);
    const size_t hstep = (size_t)HALF * RB;
    const size_t tstep = 2 * hstep;
    const unsigned ldsw = (unsigned)wid * 1024u;
    const int aoff = lds_byte(wr * 64 + fr, fq * 8), boff = lds_byte(wc * 32 + fr, fq * 8);
#define PG8_SA(b, h) (((b) * 2 + (h)) * HTB)
#define PG8_SB(b, h) ((4 + (b) * 2 + (h)) * HTB)
#define PG8_STAGE(bufoff, gbase, voff) do { _Pragma("unroll") for (int _i = 0; _i < 2; ++_i) \
        __builtin_amdgcn_global_load_lds((const unsigned*)((const char*)(gbase) + (voff)[_i]), (LAS unsigned*)(lds + (bufoff) + ldsw + _i * 8192), 16, 0, 0); } while (0)
#define PG8_STAGE_B(b, h, q) do { const bool w_ = (q) >= nt; const char* gb_ = (w_ ? nB : cB) + (size_t)(h) * hstep + (size_t)(w_ ? (q) - nt : (q)) * kstep; PG8_STAGE(PG8_SB(b, h), gb_, voffB); } while (0)
#define PG8_STAGE_A(b, h, q) do { const bool w_ = (q) >= nt; \
        if constexpr (GATHER) { const char* gb_ = (const char*)g.A + (size_t)(w_ ? (q) - nt : (q)) * kstep; unsigned go_[2]; go_[0] = w_ ? goffn[h][0] : goff[h][0]; go_[1] = w_ ? goffn[h][1] : goff[h][1]; PG8_STAGE(PG8_SA(b, h), gb_, go_); } \
        else { const char* gb_ = (w_ ? nA : cA) + (size_t)(h) * hstep + (size_t)(w_ ? (q) - nt : (q)) * kstep; PG8_STAGE(PG8_SA(b, h), gb_, voffA); } } while (0)
#define PG8_LDA(dst, b, h) do { _Pragma("unroll") for (int m = 0; m < 4; ++m) _Pragma("unroll") for (int k = 0; k < 2; ++k) dst[m][k] = *(const LAS bf16x8*)(lds + PG8_SA(b, h) + aoff + m * 2048 + k * 1024); } while (0)
#define PG8_LDB(dst, b, h) do { _Pragma("unroll") for (int n = 0; n < 2; ++n) _Pragma("unroll") for (int k = 0; k < 2; ++k) dst[n][k] = *(const LAS bf16x8*)(lds + PG8_SB(b, h) + boff + n * 2048 + k * 1024); } while (0)
#define PG8_MMA(ai, bj, At, Bt) do { __builtin_amdgcn_s_setprio(1); \
        if constexpr (FP8) { _Pragma("unroll") for (int m = 0; m < 4; ++m) _Pragma("unroll") for (int n = 0; n < 2; ++n) { \
            const i32x8 a8_ = __builtin_shufflevector(__builtin_bit_cast(i32x4, At[m][0]), __builtin_bit_cast(i32x4, At[m][1]), 0, 1, 2, 3, 4, 5, 6, 7); \
            const i32x8 b8_ = __builtin_shufflevector(__builtin_bit_cast(i32x4, Bt[n][0]), __builtin_bit_cast(i32x4, Bt[n][1]), 0, 1, 2, 3, 4, 5, 6, 7); \
            asm volatile("v_mfma_scale_f32_16x16x128_f8f6f4 %0, %1, %2, %0, %3, %3 op_sel_hi:[0,0,0]" : "+v"(acc[ai][bj][m][n]) : "v"(b8_), "v"(a8_), "v"(sc8_)); } } \
        else { _Pragma("unroll") for (int m = 0; m < 4; ++m) _Pragma("unroll") for (int n = 0; n < 2; ++n) _Pragma("unroll") for (int k = 0; k < 2; ++k) \
            acc[ai][bj][m][n] = __builtin_amdgcn_mfma_f32_16x16x32_bf16(Bt[n][k], At[m][k], acc[ai][bj][m][n], 0, 0, 0); } \
        __builtin_amdgcn_s_setprio(0); } while (0)
#define PG8_WAIT_V(n) asm volatile("s_waitcnt vmcnt(" #n ")" ::: "memory")
#define PG8_WAIT_L(n) asm volatile("s_waitcnt lgkmcnt(" #n ")" ::: "memory")
#define PG8_BAR __builtin_amdgcn_s_barrier()
#define PG8_SCHED __builtin_amdgcn_sched_barrier(0)
#define PG8_GOFF(dst, u) do { _Pragma("unroll") for (int h_ = 0; h_ < 2; ++h_) _Pragma("unroll") for (int i_ = 0; i_ < 2; ++i_) { \
        const int tk_ = g.rowtok[(u).pm * BM + h_ * HALF + RA[i_]]; dst[h_][i_] = (unsigned)((tk_ < 0 ? 0 : tk_) * RB + CA[i_] * 2); } } while (0)
    Unit cur, nxt; int ui = 0;
    if (!S.next(0, cur)) return;
    f32x4 acc[2][2][4][2];
#pragma unroll
    for (int a = 0; a < 2; ++a)
#pragma unroll
        for (int b = 0; b < 2; ++b)
#pragma unroll
            for (int m = 0; m < 4; ++m)
#pragma unroll
                for (int n = 0; n < 2; ++n) acc[a][b][m][n] = (f32x4){0.f, 0.f, 0.f, 0.f};
    bf16x8 At[4][2], B0[2][2], B1[2][2];
    const int sc8_ = 0x7f7f7f7f;
    unsigned goff[2][2], goffn[2][2];
    if constexpr (GATHER) { PG8_GOFF(goff, cur); } else { goff[0][0] = goff[0][1] = goff[1][0] = goff[1][1] = 0u; }
#pragma unroll
    for (int h_ = 0; h_ < 2; ++h_) { goffn[h_][0] = goff[h_][0]; goffn[h_][1] = goff[h_][1]; }
    const char* cA = (const char*)g.A + (GATHER ? (size_t)0 : (size_t)cur.pm * tstep);
    const char* cB = (const char*)g.Bt + ((size_t)cur.e * g.bstride) * (FP8 ? 1 : 2) + (size_t)cur.pn * tstep;
    const char* nA = cA; const char* nB = cB;
#define PG8_PRE(unit_, slot_) do { if constexpr (Epi::PRE != 0) { if (wid < Epi::PRE) \
        __builtin_amdgcn_global_load_lds((const unsigned*)((const char*)E.pre_src(unit_) + (wid * 64 + lane) * 4), (LAS unsigned*)(lds + RING_BYTES + 1024 + (slot_) * 2048 + wid * 256), 4, 0, 0); } } while (0)
    PG8_PRE(cur, 0);
    PG8_STAGE_B(0, 0, 0); PG8_STAGE_B(0, 1, 0); PG8_STAGE_A(0, 0, 0); PG8_STAGE_A(0, 1, 0);
    if (wr == 1) PG8_BAR;
    PG8_WAIT_V(2); PG8_BAR;
    PG8_STAGE_B(1, 0, 1); PG8_STAGE_A(1, 0, 1); PG8_STAGE_B(1, 1, 1);
    PG8_WAIT_V(6); PG8_BAR;
    for (;;) {
        const bool has_next = S.next(ui + 1, nxt);
        if (!has_next) nxt = cur;
        nA = (const char*)g.A + (GATHER ? (size_t)0 : (size_t)nxt.pm * tstep);
        nB = (const char*)g.Bt + ((size_t)nxt.e * g.bstride) * (FP8 ? 1 : 2) + (size_t)nxt.pn * tstep;
        if (has_next) { PG8_PRE(nxt, (ui + 1) % 3);
            if constexpr (GATHER) { if (wid < 4) __builtin_amdgcn_global_load_lds((const unsigned*)(g.rowtok + nxt.pm * BM + wid * 64 + lane), (LAS unsigned*)(lds + RING_BYTES + wid * 256), 4, 0, 0); } }
        for (int t = 0; t < nt; t += 2) {
            if constexpr (GATHER) { if (t == nt - 2 && has_next) {
#pragma unroll
                for (int h_ = 0; h_ < 2; ++h_)
#pragma unroll
                    for (int i_ = 0; i_ < 2; ++i_) { const int tk_ = *(const LAS int*)(lds + RING_BYTES + (h_ * HALF + RA[i_]) * 4); goffn[h_][i_] = (unsigned)((tk_ < 0 ? 0 : tk_) * RB + CA[i_] * 2); } } }
            PG8_LDB(B0, 0, 0); PG8_LDB(B1, 0, 1); PG8_SCHED; PG8_LDA(At, 0, 0); PG8_STAGE_A(1, 1, t + 1);
            PG8_WAIT_V(8); PG8_WAIT_L(0); PG8_BAR; PG8_MMA(0, 0, At, B0); PG8_MMA(0, 1, At, B1); PG8_BAR; PG8_SCHED;
            PG8_LDA(At, 0, 1); PG8_STAGE_B(0, 0, t + 2); PG8_STAGE_B(0, 1, t + 2); PG8_STAGE_A(0, 0, t + 2);
            PG8_WAIT_V(8); PG8_WAIT_L(0); PG8_BAR; PG8_MMA(1, 0, At, B0); PG8_MMA(1, 1, At, B1); PG8_BAR; PG8_SCHED;
            PG8_LDB(B0, 1, 0); PG8_LDB(B1, 1, 1); PG8_SCHED; PG8_LDA(At, 1, 0); PG8_STAGE_A(0, 1, t + 2);
            PG8_WAIT_V(8); PG8_WAIT_L(0); PG8_BAR; PG8_MMA(0, 0, At, B0); PG8_MMA(0, 1, At, B1); PG8_BAR; PG8_SCHED;
            PG8_LDA(At, 1, 1); PG8_STAGE_B(1, 0, t + 3); PG8_STAGE_B(1, 1, t + 3); PG8_STAGE_A(1, 0, t + 3);
            PG8_WAIT_V(8); PG8_WAIT_L(0); PG8_BAR; PG8_MMA(1, 0, At, B0); PG8_MMA(1, 1, At, B1); PG8_BAR; PG8_SCHED;
        }
        if (wr == 0) PG8_BAR;
        if constexpr (FP8) asm volatile("s_nop 15\n\ts_nop 7" ::: "memory");
        E(acc, cur, wr, wc, fr, fq, lds + RING_BYTES + 1024 + (ui % 3) * 2048);
        if (!has_next) break;
#pragma unroll
        for (int a = 0; a < 2; ++a)
#pragma unroll
            for (int b = 0; b < 2; ++b)
#pragma unroll
                for (int m = 0; m < 4; ++m)
#pragma unroll
                    for (int n = 0; n < 2; ++n) acc[a][b][m][n] = (f32x4){0.f, 0.f, 0.f, 0.f};
        cur = nxt; cA = nA; cB = nB; ++ui;
#pragma unroll
        for (int h_ = 0; h_ < 2; ++h_) { goff[h_][0] = goffn[h_][0]; goff[h_][1] = goffn[h_][1]; }
        if (wr == 1) PG8_BAR;
    }
    PG8_WAIT_V(0);
    PG8_BAR;
#undef PG8_SA
#undef PG8_SB
#undef PG8_STAGE
#undef PG8_STAGE_A
#undef PG8_STAGE_B
#undef PG8_LDA
#undef PG8_LDB
#undef PG8_MMA
#undef PG8_WAIT_V
#undef PG8_WAIT_L
#undef PG8_BAR
#undef PG8_SCHED
#undef PG8_GOFF
#undef PG8_PRE
}
}

#define XB_TMO      128
#define XB_XCNT(j)  (256  + 64 * (j))
#define XB_XSUB(j)  (1280 + 64 * (j))
#define XB_XGEN(j)  (2304 + 64 * (j))
#define XB_TOP      3328
#define XB_TOPGEN   3392
#define XCD_BAR_WORDS 3456
#define XB_SPIN_CAP (1u << 18)
__device__ __forceinline__ unsigned xb_ld(unsigned* p)              { return __hip_atomic_load(p, __ATOMIC_RELAXED, __HIP_MEMORY_SCOPE_AGENT); }
__device__ __forceinline__ unsigned xb_add(unsigned* p, unsigned v) { return __hip_atomic_fetch_add(p, v, __ATOMIC_RELAXED, __HIP_MEMORY_SCOPE_AGENT); }
__device__ __forceinline__ unsigned xb_xcc_id() { return (unsigned)__builtin_amdgcn_s_getreg((3 << 11) | 20) & 0xFu; }
#define XB_SPIN(cond, bar) do { unsigned _sp = 0; while (cond) { __builtin_amdgcn_s_sleep(1); \
    if ((++_sp & 255u) == 0u) { if (xb_ld(&(bar)[XB_TMO])) break; if (_sp > XB_SPIN_CAP) { atomicAdd(&(bar)[XB_TMO], 1u); break; } } } } while (0)
struct XcdBarrier { unsigned* bar; unsigned x; volatile LAS unsigned* st; };
__device__ __forceinline__ XcdBarrier xcd_barrier_post(unsigned* bar, volatile LAS unsigned* st) {
    XcdBarrier b; b.bar = bar; b.x = xb_xcc_id(); b.st = st;
    if (threadIdx.x == 0) (void)xb_add(&bar[XB_XCNT(b.x)], 1u);
    return b;
}
__device__ __forceinline__ void xcd_barrier_complete(unsigned* bar, unsigned x, unsigned& nloc, unsigned& nx) {
    const unsigned G = gridDim.x * gridDim.y * gridDim.z;
    unsigned sum, cnt, mine, sp = 0u;
    for (;;) {
        sum = 0u; cnt = 0u; mine = 0u;
#pragma unroll
        for (unsigned j = 0; j < 16; ++j) { const unsigned c = xb_ld(&bar[XB_XCNT(j)]); sum += c; cnt += (c > 0u) ? 1u : 0u; mine = (j == x) ? c : mine; }
        if (sum == G) break;
        __builtin_amdgcn_s_sleep(1);
        if ((++sp & 255u) == 0u) { if (xb_ld(&bar[XB_TMO])) break; if (sp > XB_SPIN_CAP) { atomicAdd(&bar[XB_TMO], 1u); break; } }
    }
    nloc = mine > 0u ? mine : 1u; nx = cnt > 0u ? cnt : 1u;
}
__device__ __forceinline__ void xcd_barrier(const XcdBarrier& b) {
    asm volatile("s_waitcnt vmcnt(0)" ::: "memory");
    __syncthreads();
    if (threadIdx.x == 0) {
        unsigned* bar = b.bar;
        __builtin_amdgcn_s_waitcnt(0);
        unsigned nloc = b.st[0], nx = b.st[1];
        if (nloc == 0u) { xcd_barrier_complete(bar, b.x, nloc, nx); b.st[0] = nloc; b.st[1] = nx; }
        const unsigned old = xb_add(&bar[XB_XSUB(b.x)], 1u);
        const unsigned gen = old / nloc;
        if (old + 1u == (gen + 1u) * nloc) {
            __builtin_amdgcn_fence(__ATOMIC_RELEASE, "agent");
            asm volatile("s_waitcnt vmcnt(0)" ::: "memory");
            const unsigned og = xb_add(&bar[XB_TOP], 1u);
            const unsigned tg = og / nx;
            if (og + 1u == (tg + 1u) * nx) xb_add(&bar[XB_TOPGEN], 1u);
            else XB_SPIN(xb_ld(&bar[XB_TOPGEN]) == tg, bar);
            __builtin_amdgcn_fence(__ATOMIC_ACQUIRE, "agent");
            xb_add(&bar[XB_XGEN(b.x)], 1u);
            asm volatile("s_waitcnt vmcnt(0)" ::: "memory");
        } else {
            XB_SPIN(xb_ld(&bar[XB_XGEN(b.x)]) == gen, bar);
            __builtin_amdgcn_fence(__ATOMIC_ACQUIRE, "agent");
            asm volatile("s_waitcnt vmcnt(0)" ::: "memory");
        }
    }
    __syncthreads();
}

struct Frame {
    LAS unsigned char* lds;
    int tid, lane, wave, vcu, G;
};
__device__ __forceinline__ float wave_sum(float v) {
#pragma unroll
    for (int o = 1; o < 64; o <<= 1) v += __shfl_xor(v, o);
    return v;
}
__device__ __forceinline__ void transpose_item(const float* W, int K, int N, int k0, int nsrc0, bf16_t* WT, int drow0, const float* gain, LAS float* scr, int lane) {
    f32x4 ld[8];
#pragma unroll
    for (int i = 0; i < 8; ++i) ld[i] = *(const f32x4*)(W + (size_t)(k0 + 8 * i + (lane >> 3)) * N + nsrc0 + 4 * (lane & 7));
#pragma unroll
    for (int i = 0; i < 8; ++i) { const int kk = 8 * i + (lane >> 3); f32x4 v = ld[i]; if (gain) v *= gain[k0 + kk]; LAS float* d = scr + kk * 33 + 4 * (lane & 7); d[0] = v[0]; d[1] = v[1]; d[2] = v[2]; d[3] = v[3]; }
    LDS_WAIT(); asm volatile("" ::: "memory");
    const int c = lane & 7;
#pragma unroll
    for (int j = 0; j < 4; ++j) { const int n = (lane >> 3) + 8 * j; const LAS float* s = scr + (8 * c) * 33 + n;
        u32x4 o; o.x = pk2(s[0 * 33], s[1 * 33]); o.y = pk2(s[2 * 33], s[3 * 33]); o.z = pk2(s[4 * 33], s[5 * 33]); o.w = pk2(s[6 * 33], s[7 * 33]);
        *(GAS u32x4*)(WT + (size_t)(drow0 + n) * K + k0 + 8 * c) = o; }
    LDS_WAIT(); asm volatile("" ::: "memory");
}
__device__ __forceinline__ void transpose_item8(const float* W, int K, int N, int k0, int nsrc0, unsigned char* WT, int drow0, const float* gain, float scale, LAS float* scr, int lane) {
    f32x4 ld[8];
#pragma unroll
    for (int i = 0; i < 8; ++i) ld[i] = *(const f32x4*)(W + (size_t)(k0 + 8 * i + (lane >> 3)) * N + nsrc0 + 4 * (lane & 7));
#pragma unroll
    for (int i = 0; i < 8; ++i) { const int kk = 8 * i + (lane >> 3); f32x4 v = ld[i] * scale; if (gain) v *= gain[k0 + kk]; LAS float* d = scr + kk * 33 + 4 * (lane & 7); d[0] = v[0]; d[1] = v[1]; d[2] = v[2]; d[3] = v[3]; }
    LDS_WAIT(); asm volatile("" ::: "memory");
    const int c = lane & 7;
#pragma unroll
    for (int j = 0; j < 4; ++j) { const int n = (lane >> 3) + 8 * j; const LAS float* s = scr + (8 * c) * 33 + n;
        u32x2 o; o.x = pk4_fp8(s[0 * 33], s[1 * 33], s[2 * 33], s[3 * 33]); o.y = pk4_fp8(s[4 * 33], s[5 * 33], s[6 * 33], s[7 * 33]);
        *(GAS u32x2*)(WT + (size_t)(drow0 + n) * K + k0 + 8 * c) = o; }
    LDS_WAIT(); asm volatile("" ::: "memory");
}
template <int MAP>
__device__ __forceinline__ void transpose_mat(const float* W, int K, int N, int ncol0, int ncols, bf16_t* WT, int roff, const float* gain, LAS float* scr, int lane, int it) {
    const int nblk = ncols / 32, kb = it / nblk, nb = it % nblk, n = 32 * nb;
    int drow;
    if (MAP == 0) drow = roff + n;
    else if (MAP == 1) drow = (n / 128) * 256 + roff + (n % 128);
    else { const int head = n / 64, d = n % 64; drow = roff + (head / 4) * 256 + (d / 32) * 128 + (head % 4) * 32; }
    transpose_item(W, K, N, 64 * kb, ncol0 + n, WT, drow, gain, scr, lane);
}

namespace epi {
using pg8::Unit;
#define EPI_ARGS const f32x4 (&acc)[2][2][4][2], const Unit& u, int wr, int wc, int fr, int fq, const LAS unsigned char* pre
__device__ __forceinline__ u32x4 pack8(f32x4 v0, f32x4 v1) { u32x4 w; w.x = cvt_pk_bf16(v0[0], v0[1]); w.y = cvt_pk_bf16(v0[2], v0[3]); w.z = cvt_pk_bf16(v1[0], v1[1]); w.w = cvt_pk_bf16(v1[2], v1[3]); return w; }
__device__ __forceinline__ void unpack8(u32x4 w, f32x4& v0, f32x4& v1) { v0 = (f32x4){bf_lo(w.x), bf_hi(w.x), bf_lo(w.y), bf_hi(w.y)}; v1 = (f32x4){bf_lo(w.z), bf_hi(w.z), bf_lo(w.w), bf_hi(w.w)}; }
__device__ __forceinline__ f32x4 silu4(f32x4 v) { return (f32x4){silu_f(v[0]), silu_f(v[1]), silu_f(v[2]), silu_f(v[3])}; }
__device__ __forceinline__ float sumsq4(f32x4 v) { return (v[0] * v[0] + v[1] * v[1]) + (v[2] * v[2] + v[3] * v[3]); }

struct EpiOG {
    static constexpr int PRE = 0;
    bf16_t* OG1;
    __device__ __forceinline__ void operator()(EPI_ARGS) const {
        const int colt = u.pn * 256 + wc * 32 + 8 * fq;
#pragma unroll
        for (int ai = 0; ai < 2; ++ai)
#pragma unroll
            for (int m = 0; m < 4; ++m) { bf16_t* rowp = OG1 + (size_t)(u.pm * 256 + ai * 128 + wr * 64 + m * 16 + fr) * D + colt;
#pragma unroll
                for (int bj = 0; bj < 2; ++bj) *(u32x4*)(rowp + bj * 128) = pack8(silu4(acc[ai][bj][m][0]), silu4(acc[ai][bj][m][1])); }
    }
};
struct EpiQFI {
    static constexpr int PRE = 4;
    __device__ __forceinline__ const void* pre_src(const Unit& u) const { return (const void*)(LB + (u.pm & 3) * 256); }
    unsigned short* base3; const float* LB;
    __device__ __forceinline__ void operator()(EPI_ARGS) const {
        const int kind = u.pm >> 2; unsigned short* base = base3 + (size_t)kind * (size_t)(64u << 20);
        const size_t toff = (size_t)(u.pn * 4 + (wc >> 1)) * 65536 + (wc & 1) * 32 + 8 * fq;
        if (kind == 1) { float lbr[2][4];
#pragma unroll
            for (int ai = 0; ai < 2; ++ai)
#pragma unroll
                for (int m = 0; m < 4; ++m) lbr[ai][m] = *(const LAS float*)(pre + (ai * 128 + wr * 64 + m * 16 + fr) * 4);
#pragma unroll
            for (int ai = 0; ai < 2; ++ai)
#pragma unroll
                for (int m = 0; m < 4; ++m) { const int ch = (u.pm & 3) * 256 + ai * 128 + wr * 64 + m * 16 + fr; unsigned short* rowp = base + toff + (size_t)ch * 64; const float lb = lbr[ai][m], om = 1.0f - lb;
#pragma unroll
                    for (int bj = 0; bj < 2; ++bj) { u32x4 w;
#pragma unroll
                        for (int n = 0; n < 2; ++n) { float g[4];
#pragma unroll
                            for (int i = 0; i < 4; ++i) { const float v = acc[ai][bj][m][n][i]; const float sg = fast_rcp(1.0f + fast_exp(-v)); g[i] = __builtin_amdgcn_logf(lb + om * sg) * 0.6931471805599453f; }
                            w[2 * n] = pk_f16(g[0], g[1]); w[2 * n + 1] = pk_f16(g[2], g[3]); }
                        *(u32x4*)(rowp + bj * 131072) = w; } } }
        else {
#pragma unroll
            for (int ai = 0; ai < 2; ++ai)
#pragma unroll
                for (int m = 0; m < 4; ++m) { const int ch = (u.pm & 3) * 256 + ai * 128 + wr * 64 + m * 16 + fr; unsigned short* rowp = base + toff + (size_t)ch * 64;
#pragma unroll
                    for (int bj = 0; bj < 2; ++bj) *(u32x4*)(rowp + bj * 131072) = pack8(acc[ai][bj][m][0], acc[ai][bj][m][1]); } }
    }
};
template <int BASE, bool OUT32, bool OUT8 = false> struct EpiRes {
    static constexpr int PRE = 0;
    static constexpr bool BASE32 = BASE == 1;
    const void* base; bf16_t* out; float* out32; u64* rowss; unsigned char* out8; const float* invr; const float* invg; float asc = 1.0f;
    __device__ __forceinline__ void operator()(EPI_ARGS) const {
        const int colt = u.pn * 256 + wc * 32 + 8 * fq; float ssr[2][4];
        constexpr int MB = BASE32 ? 2 : 4;
        f32x4 ig[2][2]; float irr[2][4];
        if (BASE == 2) {
#pragma unroll
            for (int bj = 0; bj < 2; ++bj) { ig[bj][0] = *(const f32x4*)(invg + colt + bj * 128); ig[bj][1] = *(const f32x4*)(invg + colt + bj * 128 + 4); }
#pragma unroll
            for (int ai = 0; ai < 2; ++ai)
#pragma unroll
                for (int m = 0; m < 4; ++m) irr[ai][m] = invr[u.pm * 256 + ai * 128 + wr * 64 + m * 16 + fr]; }
#pragma unroll
        for (int ai = 0; ai < 2; ++ai)
#pragma unroll
            for (int m0 = 0; m0 < 4; m0 += MB) { u32x4 bw[MB][2][BASE32 ? 2 : 1];
#pragma unroll
                for (int mi = 0; mi < MB; ++mi) { const size_t off = (size_t)(u.pm * 256 + ai * 128 + wr * 64 + (m0 + mi) * 16 + fr) * D + colt;
#pragma unroll
                    for (int bj = 0; bj < 2; ++bj) {
                        if (BASE32) { const float* bp = (const float*)base + off + bj * 128; bw[mi][bj][0] = *(const u32x4*)bp; bw[mi][bj][BASE32 ? 1 : 0] = *(const u32x4*)(bp + 4); }
                        else bw[mi][bj][0] = *(const u32x4*)((const bf16_t*)base + off + bj * 128); } }
#pragma unroll
                for (int mi = 0; mi < MB; ++mi) { const int m = m0 + mi; const size_t off = (size_t)(u.pm * 256 + ai * 128 + wr * 64 + m * 16 + fr) * D + colt; float ss = 0.f;
#pragma unroll
                    for (int bj = 0; bj < 2; ++bj) { f32x4 b0, b1;
                        if (BASE32) { b0 = __builtin_bit_cast(f32x4, bw[mi][bj][0]); b1 = __builtin_bit_cast(f32x4, bw[mi][bj][BASE32 ? 1 : 0]); }
                        else unpack8(bw[mi][bj][0], b0, b1);
                        if (BASE == 2) { const float ir = irr[ai][m]; b0 = b0 * ir * ig[bj][0]; b1 = b1 * ir * ig[bj][1]; }
                        const f32x4 h0 = acc[ai][bj][m][0] * asc + b0, h1 = acc[ai][bj][m][1] * asc + b1; ss += sumsq4(h0) + sumsq4(h1);
                        *(u32x4*)(out + off + bj * 128) = pack8(h0, h1);
                        if (OUT8) { u32x2 w8; w8.x = pk4_fp8(h0[0] * S8_H3, h0[1] * S8_H3, h0[2] * S8_H3, h0[3] * S8_H3); w8.y = pk4_fp8(h1[0] * S8_H3, h1[1] * S8_H3, h1[2] * S8_H3, h1[3] * S8_H3); *(u32x2*)(out8 + off + bj * 128) = w8; }
                        if (OUT32) { float* op = out32 + off + bj * 128; *(f32x4*)op = h0; *(f32x4*)(op + 4) = h1; } }
                    ss += __shfl_xor(ss, 16); ss += __shfl_xor(ss, 32); ssr[ai][m] = ss; } }
        if (fq == 0) {
#pragma unroll
            for (int ai = 0; ai < 2; ++ai)
#pragma unroll
                for (int m = 0; m < 4; ++m) __hip_atomic_fetch_add(rowss + u.pm * 256 + ai * 128 + wr * 64 + m * 16 + fr, (u64)(ssr[ai][m] * SS_FIX), RLX_AGENT); }
    }
};
template <bool MOE, bool OUT8 = MOE> struct EpiGU {
    static constexpr int PRE = MOE ? 4 : 8;
    __device__ __forceinline__ const void* pre_src(const Unit& u) const { return MOE ? (const void*)((const float*)rsrc + u.pm * 256) : (const void*)((const u64*)rsrc + u.pm * 256); }
    bf16_t* hid; int ldh; const void* rsrc; float asc = 1.0f;
    __device__ __forceinline__ void operator()(EPI_ARGS) const {
        const int colt = u.pn * 128 + wc * 32 + 8 * fq; float rr[2][4];
#pragma unroll
        for (int ai = 0; ai < 2; ++ai)
#pragma unroll
            for (int m = 0; m < 4; ++m) { const int rl = ai * 128 + wr * 64 + m * 16 + fr; rr[ai][m] = MOE ? *(const LAS float*)(pre + rl * 4) : rinv_of(*(const LAS u64*)(pre + rl * 8)) * asc; }
#pragma unroll
        for (int ai = 0; ai < 2; ++ai)
#pragma unroll
            for (int m = 0; m < 4; ++m) { const int row = u.pm * 256 + ai * 128 + wr * 64 + m * 16 + fr;
                const float r = rr[ai][m];
                const float c1 = r * r * (OUT8 ? S8_HID : 1.0f), c2 = -r * LOG2E; f32x4 o[2];
#pragma unroll
                for (int n = 0; n < 2; ++n) { const f32x4 ga = acc[ai][0][m][n]; const f32x4 p = ga * acc[ai][1][m][n] * c1; const f32x4 t = ga * c2;
                    f32x4 e = {__builtin_amdgcn_exp2f(t[0]), __builtin_amdgcn_exp2f(t[1]), __builtin_amdgcn_exp2f(t[2]), __builtin_amdgcn_exp2f(t[3])}; e = e + 1.0f;
                    const f32x4 sg = {fast_rcp(e[0]), fast_rcp(e[1]), fast_rcp(e[2]), fast_rcp(e[3])}; o[n] = p * sg; }
                if (OUT8) { u32x2 w8; w8.x = pk4_fp8(clamp8(o[0][0]), clamp8(o[0][1]), clamp8(o[0][2]), clamp8(o[0][3]));
                    w8.y = pk4_fp8(clamp8(o[1][0]), clamp8(o[1][1]), clamp8(o[1][2]), clamp8(o[1][3])); *(u32x2*)((unsigned char*)hid + (size_t)row * ldh + colt) = w8; }
                else *(u32x4*)(hid + (size_t)row * ldh + colt) = pack8(o[0], o[1]); }
    }
};
struct EpiQK {
    static constexpr int PRE = 0;
    bf16_t* Q2; bf16_t* K2; const u64* rowss; const float* qgain; const float* kgain; float asc = 1.0f;
    __device__ __forceinline__ void operator()(EPI_ARGS) const {
        const bool isq = u.pn < 4; const float* gn = isq ? qgain : kgain; const float osc = isq ? 0.125f * LOG2E : 1.0f;
        f32x4 gv[2][2];
#pragma unroll
        for (int bj = 0; bj < 2; ++bj)
#pragma unroll
            for (int n = 0; n < 2; ++n) gv[bj][n] = *(const f32x4*)(gn + 32 * bj + 8 * fq + 4 * n) * osc;
        bf16_t* base = isq ? Q2 + (size_t)(4 * u.pn + wc) * 64 + 8 * fq : K2 + (size_t)wc * 64 + 8 * fq; const int ld = isq ? D : 256; float rr[2][4];
#pragma unroll
        for (int ai = 0; ai < 2; ++ai)
#pragma unroll
            for (int m = 0; m < 4; ++m) rr[ai][m] = rinv_of(rowss[u.pm * 256 + ai * 128 + wr * 64 + m * 16 + fr]) * asc;
#pragma unroll
        for (int ai = 0; ai < 2; ++ai)
#pragma unroll
            for (int m = 0; m < 4; ++m) { const int row = u.pm * 256 + ai * 128 + wr * 64 + m * 16 + fr;
                const float r = rr[ai][m];
                f32x4 y[2][2]; float ss = 0.f;
#pragma unroll
                for (int bj = 0; bj < 2; ++bj)
#pragma unroll
                    for (int n = 0; n < 2; ++n) { y[bj][n] = acc[ai][bj][m][n] * r; ss += sumsq4(y[bj][n]); }
                ss += __shfl_xor(ss, 16); ss += __shfl_xor(ss, 32);
                const float s = __builtin_amdgcn_rsqf(ss * (1.0f / HD) + EPS);
#pragma unroll
                for (int bj = 0; bj < 2; ++bj) *(u32x4*)(base + (size_t)row * ld + 32 * bj) = pack8(y[bj][0] * s * gv[bj][0], y[bj][1] * s * gv[bj][1]); }
    }
};
struct EpiVT {
    static constexpr int PRE = 0;
    bf16_t* VT2; const u64* rowss; float asc = 1.0f;
    __device__ __forceinline__ void operator()(EPI_ARGS) const {
        const int tcol = u.pn * 256 + wc * 32 + 8 * fq; f32x4 rv[2][2];
#pragma unroll
        for (int bj = 0; bj < 2; ++bj)
#pragma unroll
            for (int n = 0; n < 2; ++n) {
#pragma unroll
                for (int i = 0; i < 4; ++i) rv[bj][n][i] = rinv_of(rowss[tcol + bj * 128 + 4 * n + i]) * asc; }
        const size_t toff = (size_t)(u.pn * 4 + (wc >> 1)) * 16384 + (wc & 1) * 32 + 8 * fq;
#pragma unroll
        for (int ai = 0; ai < 2; ++ai)
#pragma unroll
            for (int m = 0; m < 4; ++m) { const int ch = ai * 128 + wr * 64 + m * 16 + fr; bf16_t* rowp = VT2 + toff + (size_t)ch * 64;
#pragma unroll
                for (int bj = 0; bj < 2; ++bj) *(u32x4*)(rowp + bj * 32768) = pack8(acc[ai][bj][m][0] * rv[bj][0], acc[ai][bj][m][1] * rv[bj][1]); }
    }
};
template <bool FIRST> struct EpiMoeDown {
    static constexpr int PRE = 0;
    float* out; const int* rtok; const float* rg; bf16_t* h3b; unsigned char* dummy;
    __device__ __forceinline__ void operator()(EPI_ARGS) const {
        const int colt = u.pn * 256 + wc * 32 + 8 * fq; int tk[2][4]; float gt[2][4];
#pragma unroll
        for (int ai = 0; ai < 2; ++ai)
#pragma unroll
            for (int m = 0; m < 4; ++m) { const int prow = u.pm * 256 + ai * 128 + wr * 64 + m * 16 + fr; tk[ai][m] = rtok[prow]; gt[ai][m] = rg[prow]; }
        u32x4 bw[2][4][2];
#pragma unroll
        for (int ai = 0; ai < 2; ++ai)
#pragma unroll
            for (int m = 0; m < 4; ++m) { const int tok = tk[ai][m]; const size_t off = (size_t)(tok < 0 ? 0 : tok) * D + colt;
#pragma unroll
                for (int bj = 0; bj < 2; ++bj) bw[ai][m][bj] = *(const u32x4*)(h3b + off + bj * 128); }
#pragma unroll
        for (int ai = 0; ai < 2; ++ai) {
#pragma unroll
            for (int m = 0; m < 4; ++m) { const int tok = tk[ai][m]; const float g = gt[ai][m]; const size_t off = (size_t)(tok < 0 ? 0 : tok) * D + colt;
                bf16_t* pb = tok < 0 ? (bf16_t*)dummy + (colt & 1023) : h3b + off; float* pf = tok < 0 ? (float*)dummy + (colt & 1023) : out + off;
#pragma unroll
                for (int bj = 0; bj < 2; ++bj) { f32x4 o0, o1; unpack8(bw[ai][m][bj], o0, o1); o0 += acc[ai][bj][m][0] * g; o1 += acc[ai][bj][m][1] * g;
                    if (FIRST) *(u32x4*)(pb + bj * 128) = pack8(o0, o1);
                    else { float* p = pf + bj * 128; *(f32x4*)p = o0; *(f32x4*)(p + 4) = o1; } } } }
    }
};
#undef EPI_ARGS
}

struct Ptrs {
    const float *x, *w_in, *hlb, *gnorm, *w_out, *w_q, *q_gain, *sink, *w_o, *kv_norm, *kv_w, *k_gain, *rel_bias, *attn_norm, *ffn_norm, *ffn_wg, *ffn_wu, *ffn_wd, *router, *moe_wg, *moe_wu, *moe_wd;
    float* out; unsigned char* ws;
};
namespace wconv {
constexpr int I_QO = 16 * 32, I_FI = 16 * 96, I_OUT = 16 * 32, I_G = 16 * 88, I_DN = 44 * 32, I_Q = 16 * 32, I_KV = 16 * 16, I_O = 16 * 32;
constexpr int I_MG = 16 * 112, I_MD = 56 * 32;
constexpr int N_SMALL = I_QO + I_FI + I_OUT + 2 * I_G + I_DN + I_Q + I_KV + I_O;
constexpr int N_MOE = NE * (2 * I_MG + I_MD);
constexpr int N_FIRST = I_QO + I_FI;
constexpr int N_ALL = N_SMALL + N_MOE;
struct TItem { const float* src; int K, N, k0, drow0, fp8; unsigned char* dst; const float* gain; float scale; };
__device__ __forceinline__ TItem decode(const Ptrs& P, int it) {
    unsigned char* ws = P.ws;
    TItem t; t.gain = nullptr; t.scale = 1.0f; t.fp8 = 0; int r = it;
#define TI_SET(W_, K_, N_, kb_, nsrc_, dst_, drow_) do { t.src = (W_) + (nsrc_); t.K = (K_); t.N = (N_); t.k0 = 64 * (kb_); t.dst = (unsigned char*)(dst_); t.drow0 = (drow_); } while (0)
    if (r < I_QO) { const int kb = r / 32, n = 32 * (r % 32); TI_SET(P.w_in, D, 4 * D, kb, 3072 + n, ws + WS_WQO, n); return t; } r -= I_QO;
    if (r < I_FI) { const int kb = r / 96, n = 32 * (r % 96); TI_SET(P.w_in, D, 4 * D, kb, n, ws + WS_WFI, n); return t; } r -= I_FI;
    if (r < I_OUT) { const int kb = r / 32, n = 32 * (r % 32); TI_SET(P.w_out, D, D, kb, n, ws + WS_WOUT, n); return t; } r -= I_OUT;
    if (r < 2 * I_G) { const bool up = r >= I_G; if (up) r -= I_G; const int kb = r / 88, n = 32 * (r % 88);
        TI_SET(up ? P.ffn_wu : P.ffn_wg, D, FF0, kb, n, ws + WS_WGU, (n / 128) * 256 + (up ? 128 : 0) + (n % 128)); t.gain = P.ffn_norm; if (FFN_GU_FP8) { t.fp8 = 1; t.scale = S8_WGU; } return t; } r -= 2 * I_G;
    if (r < I_DN) { const int kb = r / 32, n = 32 * (r % 32); TI_SET(P.ffn_wd, FF0, D, kb, n, ws + WS_WDN, n); if (FFN_DOWN_FP8) { t.fp8 = 1; t.scale = S8_WDN; } return t; } r -= I_DN;
    if (r < I_Q) { const int kb = r / 32, n = 32 * (r % 32), head = n / 64, d = n % 64;
        TI_SET(P.w_q, D, D, kb, n, ws + WS_WQK, (head / 4) * 256 + (d / 32) * 128 + (head % 4) * 32); t.gain = P.attn_norm + D; if (QKV_FP8) { t.fp8 = 1; t.scale = S8_WQ; } return t; } r -= I_Q;
    if (r < I_KV) { const int kb = r / 16, n = 32 * (r % 16);
        if (n < 256) { const int head = n / 64, d = n % 64; TI_SET(P.kv_w, D, 512, kb, n, ws + WS_WQK, 1024 + (d / 32) * 128 + head * 32); }
        else TI_SET(P.kv_w, D, 512, kb, n, ws + WS_WV, n - 256);
        t.gain = P.kv_norm; if (QKV_FP8) { t.fp8 = 1; t.scale = S8_WQ; } return t; } r -= I_KV;
    if (r < I_O) { const int kb = r / 32, n = 32 * (r % 32); TI_SET(P.w_o, D, D, kb, n, ws + WS_WO, n); if (WO_FP8) { t.fp8 = 1; t.scale = S8_WO; } return t; } r -= I_O;
    const int e = r / (2 * I_MG + I_MD); r -= e * (2 * I_MG + I_MD); t.fp8 = 1;
    if (r < 2 * I_MG) { const bool up = r >= I_MG; if (up) r -= I_MG; const int kb = r / (FFE / 32), n = 32 * (r % (FFE / 32));
        TI_SET((up ? P.moe_wu : P.moe_wg) + (size_t)e * D * FFE, D, FFE, kb, n, ws + WS_MGU + (size_t)e * 2 * FFE * D, (n / 128) * 256 + (up ? 128 : 0) + (n % 128)); t.gain = P.ffn_norm + D; t.scale = S8_WGU; return t; } r -= 2 * I_MG;
    { const int kb = r / 32, n = 32 * (r % 32); TI_SET(P.moe_wd + (size_t)e * FFE * D, FFE, D, kb, n, ws + WS_MDN + (size_t)e * D * FFE, n); t.scale = S8_WDN; }
#undef TI_SET
    return t;
}
__device__ __forceinline__ void load(const TItem& t, f32x4 (&ld)[8], float (&gv)[8], int lane, const float* dummy) {
    const float* gp = t.gain ? t.gain : dummy;
#pragma unroll
    for (int i = 0; i < 8; ++i) { ld[i] = __builtin_nontemporal_load((const f32x4*)(t.src + (size_t)(t.k0 + 8 * i + (lane >> 3)) * t.N + 4 * (lane & 7)));     gv[i] = gp[(t.k0 + 8 * i + (lane >> 3)) & 1023]; }
}
__device__ __forceinline__ void finish(const TItem& cur, const f32x4 (&ld)[8], const float (&gv)[8], LAS float* scr, int lane) {
    const float gm = cur.gain ? 1.0f : 0.0f;
#pragma unroll
    for (int i = 0; i < 8; ++i) { const int kk = 8 * i + (lane >> 3); const f32x4 v = ld[i] * (cur.scale * ((gv[i] - 1.0f) * gm + 1.0f)); LAS float* d = scr + kk * 33 + 4 * (lane & 7); d[0] = v[0]; d[1] = v[1]; d[2] = v[2]; d[3] = v[3]; }
    LDS_WAIT(); asm volatile("" ::: "memory");
    { const int c = lane & 7;
#pragma unroll
      for (int j = 0; j < 4; ++j) { const int n = (lane >> 3) + 8 * j; const LAS float* sp = scr + (8 * c) * 33 + n;
          if (cur.fp8) { u32x2 o; o.x = pk4_fp8(sp[0 * 33], sp[1 * 33], sp[2 * 33], sp[3 * 33]); o.y = pk4_fp8(sp[4 * 33], sp[5 * 33], sp[6 * 33], sp[7 * 33]);
              *(GAS u32x2*)(cur.dst + (size_t)(cur.drow0 + n) * cur.K + cur.k0 + 8 * c) = o; }
          else { u32x4 o; o.x = pk2(sp[0 * 33], sp[1 * 33]); o.y = pk2(sp[2 * 33], sp[3 * 33]); o.z = pk2(sp[4 * 33], sp[5 * 33]); o.w = pk2(sp[6 * 33], sp[7 * 33]);
              *(GAS u32x4*)((bf16_t*)cur.dst + (size_t)(cur.drow0 + n) * cur.K + cur.k0 + 8 * c) = o; } } }
    LDS_WAIT(); asm volatile("" ::: "memory");
}
}
__device__ __forceinline__ void p0_prologue(Frame& F, const Ptrs& P) {
    unsigned char* ws = P.ws;
    const int tid_ = fresh_tid(), lane = tid_ & 63, wave_ = __builtin_amdgcn_readfirstlane(tid_ >> 6);
    LAS float* scr = (LAS float*)(F.lds + wave_ * 16384);
    const int gw = F.vcu * 8 + wave_, NGW = F.G * 8;
    { f32x4 ldc[8], ldn[8]; float gvc[8], gvn[8];
      int it = gw; wconv::TItem cur{}; if (it < wconv::N_FIRST) { cur = wconv::decode(P, it); wconv::load(cur, ldc, gvc, lane, P.attn_norm); }
      for (; it < wconv::N_FIRST; it += NGW) {
          const bool more = it + NGW < wconv::N_FIRST; wconv::TItem nxt = cur;
          if (more) { nxt = wconv::decode(P, it + NGW); wconv::load(nxt, ldn, gvn, lane, P.attn_norm); }
          wconv::finish(cur, ldc, gvc, scr, lane);
          cur = nxt;
#pragma unroll
          for (int i = 0; i < 8; ++i) { ldc[i] = ldn[i]; gvc[i] = gvn[i]; } } }
    if (blockIdx.x == 0) { for (int c = tid_; c < D; c += 512) { ((float*)(ws + WS_INVG))[c] = 1.0f / P.attn_norm[c]; const float a = P.hlb[c], b = P.hlb[D + c], d = P.hlb[2 * D + c]; const float mx = fmaxf(a, fmaxf(b, d));
        const float ea = __expf(a - mx), eb = __expf(b - mx), ed = __expf(d - mx); ((float*)(ws + WS_LB))[c] = ea / (ea + eb + ed); } }
    bf16_t* XN = (bf16_t*)(ws + WS_XN);
    f32x4 gn[4];
#pragma unroll
    for (int j = 0; j < 4; ++j) gn[j] = ((const f32x4*)P.attn_norm)[lane + 64 * j];
    for (int m = 2 * gw; m < T; m += 2 * NGW) {
        f32x4 v[2][4]; float sq[2];
#pragma unroll
        for (int rr = 0; rr < 2; ++rr) { const GAS f32x4* xr = (const GAS f32x4*)(P.x + (size_t)(m + rr) * D) + lane;
#pragma unroll
            for (int j = 0; j < 4; ++j) v[rr][j] = xr[64 * j]; }
#pragma unroll
        for (int rr = 0; rr < 2; ++rr) { float a = 0.f;
#pragma unroll
            for (int j = 0; j < 4; ++j) a += (v[rr][j][0] * v[rr][j][0] + v[rr][j][1] * v[rr][j][1]) + (v[rr][j][2] * v[rr][j][2] + v[rr][j][3] * v[rr][j][3]);
            sq[rr] = a; }
#pragma unroll
        for (int o = 1; o < 64; o <<= 1) { sq[0] += __shfl_xor(sq[0], o); sq[1] += __shfl_xor(sq[1], o); }
#pragma unroll
        for (int rr = 0; rr < 2; ++rr) { const float r = __builtin_amdgcn_rsqf(sq[rr] * (1.f / D) + EPS); if (lane == 0) ((float*)(ws + WS_INVR0))[m + rr] = 1.0f / r;
            GAS u32x2* o8 = (GAS u32x2*)(XN + (size_t)(m + rr) * D) + lane;
#pragma unroll
            for (int j = 0; j < 4; ++j) { const f32x4 y = v[rr][j] * r * gn[j]; u32x2 w; w.x = cvt_pk_bf16(y[0], y[1]); w.y = cvt_pk_bf16(y[2], y[3]); o8[64 * j] = w; } }
    }
}

__device__ __forceinline__ void scan_state_pass(Frame& F, const Ptrs& P, const unsigned short* GT, const bf16_t* VT, float* SST) {
    constexpr int KP = 144, L_K = 0, L_V = 32 * KP, L_D = L_V + 128 * KP, BUF = L_D + 128;
    LAS unsigned char* lds = F.lds;
    const int tid = fresh_tid(), lane = tid & 63, w = __builtin_amdgcn_readfirstlane(tid >> 6), l15 = lane & 15, g = lane >> 4, ch = tid >> 4, sg = tid & 15;
    const int cNGW = F.G * 8; int cit = wconv::N_FIRST + F.vcu * 8 + w; bool cpend = false; wconv::TItem cti{}; f32x4 cld[8]; float cgv[8];
    LAS float* cscr = (LAS float*)(lds + 2 * BUF + w * 8448);
    static_assert(2 * BUF + 8 * 8448 <= PHASE_LDS, "state pass LDS");
    for (int item = F.vcu; item < BATCH * HG_H * 4; item += F.G) {
        const int bh = item >> 2, kq = item & 3, b = bh >> 3, h = bh & 7;
        const size_t blk0 = (size_t)b * NCHK;
        const unsigned short* gsrc = GT + (blk0 * 1024 + h * 128 + 32 * kq + ch) * 64 + 4 * sg;
        const bf16_t* vsrc = VT + (blk0 * 1024 + h * 128) * 64 + (size_t)tid * 8;
        u32x2 rg[2]; u32x4 rv[2][2];
#define SP_LOAD(set, cc) do { rg[set] = *(const u32x2*)(gsrc + (size_t)(cc) * 65536); rv[set][0] = *(const u32x4*)(vsrc + (size_t)(cc) * 65536); rv[set][1] = *(const u32x4*)(vsrc + (size_t)(cc) * 65536 + 4096); } while (0)
        f32x4 S[2]; S[0] = (f32x4){0.f, 0.f, 0.f, 0.f}; S[1] = S[0];
        SP_LOAD(0, 0); SP_LOAD(1, 1);
#define SP_ELEM(set, cc) do { LAS unsigned char* bf_ = lds + (set) * BUF; \
            { const unsigned w0_ = rg[set].x, w1_ = rg[set].y;   const f16x2 p0 = __builtin_bit_cast(f16x2, w0_), p1 = __builtin_bit_cast(f16x2, w1_); const float gl0 = (float)p0[0], gl1 = (float)p0[1], gl2 = (float)p1[0], gl3 = (float)p1[1]; \
              const float c0 = gl0, c1 = c0 + gl1, c2 = c1 + gl2, c3 = c2 + gl3; float inc = c3; \
              _Pragma("unroll") for (int o_ = 1; o_ < 16; o_ <<= 1) { const float up = __shfl_up(inc, o_, 16); if (sg >= o_) inc += up; } \
              const float bl = __shfl(inc, 15, 16), off = inc - c3; \
              const float k0 = (1.0f - fast_exp(gl0)) * fast_exp(bl - (off + c0)), k1 = (1.0f - fast_exp(gl1)) * fast_exp(bl - (off + c1)), k2 = (1.0f - fast_exp(gl2)) * fast_exp(bl - (off + c2)), k3 = (1.0f - fast_exp(gl3)) * fast_exp(bl - (off + c3)); \
              u32x2 kw; kw.x = cvt_pk_bf16(k0, k1); kw.y = cvt_pk_bf16(k2, k3); *(LAS u32x2*)(bf_ + L_K + ch * KP + sg * 8) = kw; \
              if (sg == 0) *(LAS float*)(bf_ + L_D + ch * 4) = fast_exp(bl); } \
            *(LAS u32x4*)(bf_ + L_V + (tid >> 3) * KP + (tid & 7) * 16) = rv[set][0]; *(LAS u32x4*)(bf_ + L_V + (64 + (tid >> 3)) * KP + (tid & 7) * 16) = rv[set][1]; \
            if ((cc) + 2 < NCHK) SP_LOAD(set, (cc) + 2); } while (0)
#define SP_MMA(set, cc) do { const LAS unsigned char* bf_ = lds + (set) * BUF; \
            _Pragma("unroll") for (int kt = 0; kt < 2; ++kt) { const f32x4 dv = *(const LAS f32x4*)(bf_ + L_D + (16 * kt + 4 * g) * 4); f32x4 cacc = S[kt] * dv; \
                _Pragma("unroll") for (int s2 = 0; s2 < 2; ++s2) { const bf16x8 a_ = *(const LAS bf16x8*)(bf_ + L_K + (16 * kt + l15) * KP + (32 * s2 + 8 * g) * 2); const bf16x8 b_ = *(const LAS bf16x8*)(bf_ + L_V + (16 * w + l15) * KP + (32 * s2 + 8 * g) * 2); \
                    cacc = __builtin_amdgcn_mfma_f32_16x16x32_bf16(a_, b_, cacc, 0, 0, 0); } \
                S[kt] = cacc; } \
            if ((((cc) & 7) == 7) && (cc) + 1 < NCHK) { float* dst = SST + (((size_t)bh * 16 + (((cc) + 1) >> 3)) * 128 + 32 * kq) * 128 + 16 * w + l15; \
                _Pragma("unroll") for (int kt = 0; kt < 2; ++kt) _Pragma("unroll") for (int r = 0; r < 4; ++r) dst[(size_t)(16 * kt + 4 * g + r) * 128] = S[kt][r]; } } while (0)
        for (int c = 0; c < NCHK; c += 2) {
            if (((c >> 1) & 1) == 0) { if (cit < wconv::N_ALL) { cti = wconv::decode(P, cit); wconv::load(cti, cld, cgv, lane, P.attn_norm); cpend = true; cit += cNGW; } }
            else if (cpend) { wconv::finish(cti, cld, cgv, cscr, lane); cpend = false; }
            SP_ELEM(0, c); LDS_WAIT(); __syncthreads(); SP_MMA(0, c);
            SP_ELEM(1, c + 1); LDS_WAIT(); __syncthreads(); SP_MMA(1, c + 1); }
        __syncthreads();
#undef SP_LOAD
#undef SP_ELEM
#undef SP_MMA
    }
    if (cpend) { wconv::finish(cti, cld, cgv, cscr, lane); cpend = false; }
    for (; cit < wconv::N_ALL; cit += cNGW) { cti = wconv::decode(P, cit); wconv::load(cti, cld, cgv, lane, P.attn_norm); wconv::finish(cti, cld, cgv, cscr, lane); }
}
struct OPre { u32x4 pg[2], pq[2], pvv[2]; };
__device__ __forceinline__ void op_load(OPre& P, const unsigned short* GT, const bf16_t* QT, const bf16_t* VT, size_t to_, int tid) {
    const int ch = tid >> 2, seg = tid & 3;
    const u32x4* gp_ = (const u32x4*)(GT + to_ + ch * 64 + 16 * seg); P.pg[0] = gp_[0]; P.pg[1] = gp_[1];
    const u32x4* qp_ = (const u32x4*)(QT + to_ + ch * 64 + 16 * seg); P.pq[0] = qp_[0]; P.pq[1] = qp_[1];
    P.pvv[0] = *(const u32x4*)(VT + to_ + (size_t)tid * 8); P.pvv[1] = *(const u32x4*)(VT + to_ + (size_t)tid * 8 + 4096);
}
namespace opl { constexpr int QP = 272, KP = 144, L_QE = 0, L_KE = 64 * QP, L_KD = 2 * 64 * QP, L_VT = L_KD + 128 * KP, L_D = L_VT + 128 * KP, BUFB = L_D + 512, L_O = 2 * BUFB, L_RED = L_O + 64 * QP;
    static_assert(L_RED + 1024 <= PHASE_LDS, "scan LDS"); }
__device__ __forceinline__ void op_elem(LAS unsigned char* lb, const OPre& P, int tid) {
    using namespace opl;
    const int ch = tid >> 2, seg = tid & 3;
    float gl[16], qv[16];
    { const unsigned gw_[8] = {P.pg[0].x, P.pg[0].y, P.pg[0].z, P.pg[0].w, P.pg[1].x, P.pg[1].y, P.pg[1].z, P.pg[1].w}; const unsigned qw_[8] = {P.pq[0].x, P.pq[0].y, P.pq[0].z, P.pq[0].w, P.pq[1].x, P.pq[1].y, P.pq[1].z, P.pq[1].w};
#pragma unroll
      for (int i = 0; i < 8; ++i) { const f16x2 p = __builtin_bit_cast(f16x2, gw_[i]); gl[2 * i] = (float)p[0]; gl[2 * i + 1] = (float)p[1]; qv[2 * i] = bf_lo(qw_[i]); qv[2 * i + 1] = bf_hi(qw_[i]); } }
    float cs[16]; { float a = 0.f;
#pragma unroll
      for (int i = 0; i < 16; ++i) { a += gl[i]; cs[i] = a; } }
    float inc = cs[15]; { const float u1 = __shfl_up(inc, 1, 4); if (seg >= 1) inc += u1; const float u2 = __shfl_up(inc, 2, 4); if (seg >= 2) inc += u2; }
    const float blast = __shfl(inc, 3, 4), off = inc - cs[15];
    unsigned kdw[8];
#pragma unroll
    for (int i = 0; i < 16; i += 2) { float kd2[2], qe2[2], ke2[2];
#pragma unroll
        for (int j = 0; j < 2; ++j) { const int ii = i + j; const float bt = off + cs[ii]; const float kk = 1.0f - fast_exp(gl[ii]);
            qe2[j] = qv[ii] * fast_exp(bt); ke2[j] = kk * fast_exp(-fmaxf(bt, -80.f)); kd2[j] = kk * fast_exp(blast - bt); }
        const unsigned qw = cvt_pk_bf16(qe2[0], qe2[1]), kw = cvt_pk_bf16(ke2[0], ke2[1]); const int t = 16 * seg + i;
        *(LAS bf16_t*)(lb + L_QE + t * QP + ch * 2) = (bf16_t)qw; *(LAS bf16_t*)(lb + L_QE + (t + 1) * QP + ch * 2) = (bf16_t)(qw >> 16);
        *(LAS bf16_t*)(lb + L_KE + t * QP + ch * 2) = (bf16_t)kw; *(LAS bf16_t*)(lb + L_KE + (t + 1) * QP + ch * 2) = (bf16_t)(kw >> 16);
        kdw[i >> 1] = cvt_pk_bf16(kd2[0], kd2[1]); }
    *(LAS u32x4*)(lb + L_KD + ch * KP + seg * 32) = (u32x4){kdw[0], kdw[1], kdw[2], kdw[3]}; *(LAS u32x4*)(lb + L_KD + ch * KP + seg * 32 + 16) = (u32x4){kdw[4], kdw[5], kdw[6], kdw[7]};
    if (seg == 0) *(LAS float*)(lb + L_D + ch * 4) = fast_exp(blast);
    *(LAS u32x4*)(lb + L_VT + (tid >> 3) * KP + (tid & 7) * 16) = P.pvv[0]; *(LAS u32x4*)(lb + L_VT + (64 + (tid >> 3)) * KP + (tid & 7) * 16) = P.pvv[1];
}
__device__ __forceinline__ void op_mma(const LAS unsigned char* lb, LAS unsigned char* lds, f32x16 (&S)[4], int tt, int et, int tid) {
    using namespace opl;
    const int l31 = tid & 31, hh = (tid >> 5) & 1;
    f32x16 oacc = {};
    bf16x8 qbf[8];
#pragma unroll
    for (int kk = 0; kk < 8; ++kk) qbf[kk] = *(const LAS bf16x8*)(lb + L_QE + (32 * tt + l31) * QP + (16 * kk + 8 * hh) * 2);
    for (int st = 0; st <= tt; ++st) { f32x16 sacc = {}; bf16x8 kaf[8]; u32x4 vw[2];
#pragma unroll
        for (int kk = 0; kk < 8; ++kk) kaf[kk] = *(const LAS bf16x8*)(lb + L_KE + (32 * st + l31) * QP + (16 * kk + 8 * hh) * 2);
#pragma unroll
        for (int s2 = 0; s2 < 2; ++s2) { const LAS unsigned char* vb = lb + L_VT + (32 * et + l31) * KP + (32 * st + 16 * s2 + 4 * hh) * 2;
            const u32x2 lo = *(const LAS u32x2*)vb, hi = *(const LAS u32x2*)(vb + 16); vw[s2] = (u32x4){lo.x, lo.y, hi.x, hi.y}; }
        LDS_WAIT(); __builtin_amdgcn_sched_barrier(0);
#pragma unroll
        for (int kk = 0; kk < 8; ++kk) sacc = __builtin_amdgcn_mfma_f32_32x32x16_bf16(kaf[kk], qbf[kk], sacc, 0, 0, 0);
        if (st == tt) {
#pragma unroll
            for (int r = 0; r < 16; ++r) { const int sl = (r & 3) + 8 * (r >> 2) + 4 * hh; if (sl > l31) sacc[r] = 0.f; } }
#pragma unroll
        for (int s2 = 0; s2 < 2; ++s2) { u32x4 pw; pw.x = cvt_pk_bf16_n(sacc[8 * s2 + 0], sacc[8 * s2 + 1]); pw.y = cvt_pk_bf16_n(sacc[8 * s2 + 2], sacc[8 * s2 + 3]);
            pw.z = cvt_pk_bf16_n(sacc[8 * s2 + 4], sacc[8 * s2 + 5]); pw.w = cvt_pk_bf16_n(sacc[8 * s2 + 6], sacc[8 * s2 + 7]);
            oacc = __builtin_amdgcn_mfma_f32_32x32x16_bf16(__builtin_bit_cast(bf16x8, vw[s2]), __builtin_bit_cast(bf16x8, pw), oacc, 0, 0, 0); } }
    { u32x4 bwf[8];
#pragma unroll
      for (int kt = 0; kt < 4; ++kt)
#pragma unroll
          for (int s2 = 0; s2 < 2; ++s2) { const LAS unsigned char* qb = lb + L_QE + (32 * tt + l31) * QP + (32 * kt + 16 * s2 + 4 * hh) * 2;
              const u32x2 lo = *(const LAS u32x2*)qb, hi = *(const LAS u32x2*)(qb + 16); bwf[2 * kt + s2] = (u32x4){lo.x, lo.y, hi.x, hi.y}; }
      LDS_WAIT(); __builtin_amdgcn_sched_barrier(0);
#pragma unroll
      for (int kt = 0; kt < 4; ++kt)
#pragma unroll
          for (int s2 = 0; s2 < 2; ++s2) { u32x4 aw; aw.x = cvt_pk_bf16_n(S[kt][8 * s2 + 0], S[kt][8 * s2 + 1]); aw.y = cvt_pk_bf16_n(S[kt][8 * s2 + 2], S[kt][8 * s2 + 3]);
              aw.z = cvt_pk_bf16_n(S[kt][8 * s2 + 4], S[kt][8 * s2 + 5]); aw.w = cvt_pk_bf16_n(S[kt][8 * s2 + 6], S[kt][8 * s2 + 7]);
              oacc = __builtin_amdgcn_mfma_f32_32x32x16_bf16(__builtin_bit_cast(bf16x8, aw), __builtin_bit_cast(bf16x8, bwf[2 * kt + s2]), oacc, 0, 0, 0); } }
    { bf16x8 bvf[4];
#pragma unroll
      for (int ss = 0; ss < 4; ++ss) bvf[ss] = *(const LAS bf16x8*)(lb + L_VT + (32 * et + l31) * KP + (16 * ss + 8 * hh) * 2);
#pragma unroll
      for (int kt = 0; kt < 4; ++kt) { f32x16 cacc; bf16x8 af[4]; f32x4 dvf[4];
#pragma unroll
          for (int i = 0; i < 4; ++i) dvf[i] = *(const LAS f32x4*)(lb + L_D + (32 * kt + 8 * i + 4 * hh) * 4);
#pragma unroll
          for (int ss = 0; ss < 4; ++ss) af[ss] = *(const LAS bf16x8*)(lb + L_KD + (32 * kt + l31) * KP + (16 * ss + 8 * hh) * 2);
          LDS_WAIT(); __builtin_amdgcn_sched_barrier(0);
#pragma unroll
          for (int i = 0; i < 4; ++i)
#pragma unroll
              for (int j = 0; j < 4; ++j) cacc[4 * i + j] = S[kt][4 * i + j] * dvf[i][j];
#pragma unroll
          for (int ss = 0; ss < 4; ++ss) cacc = __builtin_amdgcn_mfma_f32_32x32x16_bf16(af[ss], bvf[ss], cacc, 0, 0, 0);
          S[kt] = cacc; } }
    float ssq = 0.f;
#pragma unroll
    for (int r = 0; r < 16; ++r) ssq += oacc[r] * oacc[r];
    ssq += __shfl_xor(ssq, 32);
    if (hh == 0) ((LAS float*)(lds + L_RED))[et * 64 + 32 * tt + l31] = ssq;
#pragma unroll
    for (int i = 0; i < 4; ++i) *(LAS u32x2*)(lds + L_O + (32 * tt + l31) * QP + (32 * et + 8 * i + 4 * hh) * 2) = (u32x2){cvt_pk_bf16_n(oacc[4 * i], oacc[4 * i + 1]), cvt_pk_bf16_n(oacc[4 * i + 2], oacc[4 * i + 3])};
}
__device__ __forceinline__ void scan_output_pass(Frame& F, const bf16_t* QT, const unsigned short* GT, const bf16_t* VT, const float* SST, const bf16_t* OG1, const float* gnorm, bf16_t* OGATED) {
    using namespace opl;
    LAS unsigned char* lds = F.lds;
#define OP_FRESH() ({ int t_ = tid0; asm volatile("" : "+v"(t_)); t_; })
    const int tid0 = fresh_tid(), w = __builtin_amdgcn_readfirstlane(tid0 >> 6), tt = w & 1, et = w >> 1;
    const bool elem_first = w < 4;
    for (int item = F.vcu; item < BATCH * HG_H * 16; item += F.G) {
        int tid = tid0; asm volatile("" : "+v"(tid));
        const int lane = tid & 63, l31 = lane & 31, hh = lane >> 5;
        const int ft0 = tid >> 3, fe = tid & 7;
        const int bh = item >> 4, sc = item & 15, b = bh >> 3, h = bh & 7;
        const size_t blk0 = (size_t)b * NCHK + (size_t)sc * 8;
        f32x16 S[4];
        if (sc == 0) {
#pragma unroll
            for (int kt = 0; kt < 4; ++kt) S[kt] = (f32x16){};
        } else { const float* src = SST + (((size_t)bh * 16 + sc) * 128) * 128 + 32 * et + l31;
#pragma unroll
            for (int kt = 0; kt < 4; ++kt)
#pragma unroll
                for (int r = 0; r < 16; ++r) S[kt][r] = src[(size_t)(32 * kt + (r & 3) + 8 * (r >> 2) + 4 * hh) * 128]; }
        const size_t tile0 = (blk0 * 1024 + h * 128) * 64;
        OPre P;
        op_load(P, GT, QT, VT, tile0, tid);
        op_elem(lds, P, tid);
        op_load(P, GT, QT, VT, tile0 + 65536, tid);
        LDS_WAIT(); __syncthreads();
        for (int c = 0; c < 8; ++c) {
            int ft = ft0; asm volatile("" : "+v"(ft));
            const u32x4* ogp = (const u32x4*)(OG1 + ((blk0 + c) * 64 + ft) * D + h * 128 + 16 * fe); const u32x4 og0 = ogp[0], og1 = ogp[1];
            LAS unsigned char* lcur = lds + (c & 1) * BUFB; LAS unsigned char* lnxt = lds + ((c & 1) ^ 1) * BUFB;
            if (elem_first) {
                if (c + 1 < 8) { { const int t_ = OP_FRESH(); op_elem(lnxt, P, t_); if (c + 2 < 8) op_load(P, GT, QT, VT, tile0 + (size_t)(c + 2) * 65536, t_); } }
                op_mma(lcur, lds, S, tt, et, OP_FRESH());
            } else {
                op_mma(lcur, lds, S, tt, et, OP_FRESH());
                if (c + 1 < 8) { { const int t_ = OP_FRESH(); op_elem(lnxt, P, t_); if (c + 2 < 8) op_load(P, GT, QT, VT, tile0 + (size_t)(c + 2) * 65536, t_); } }
            }
            LDS_WAIT(); __syncthreads();
            { const LAS float* red = (const LAS float*)(lds + L_RED); const float rinv = __builtin_amdgcn_rsqf(((red[ft] + red[64 + ft]) + (red[128 + ft] + red[192 + ft])) * (1.0f / HG_DK) + EPS);
              const u32x4 o0 = *(const LAS u32x4*)(lds + L_O + ft * QP + 32 * fe), o1 = *(const LAS u32x4*)(lds + L_O + ft * QP + 32 * fe + 16);
              f32x4 ov[4]; epi::unpack8(o0, ov[0], ov[1]); epi::unpack8(o1, ov[2], ov[3]);
#pragma unroll
              for (int i = 0; i < 4; ++i) ov[i] = ov[i] * rinv * *(const f32x4*)(gnorm + 16 * fe + 4 * i);
              f32x4 g0, g1, g2, g3; epi::unpack8(og0, g0, g1); epi::unpack8(og1, g2, g3);
              bf16_t* dst = OGATED + ((blk0 + c) * 64 + ft) * D + h * 128 + 16 * fe;
              *(u32x4*)dst = epi::pack8(ov[0] * g0, ov[1] * g1); *(u32x4*)(dst + 8) = epi::pack8(ov[2] * g2, ov[3] * g3); }
            LDS_WAIT(); __syncthreads();
        }
    }
}

__device__ __forceinline__ void attn_phase(Frame& F, const bf16_t* Q2, const bf16_t* K2, const bf16_t* VT2, const float* rel_bias, const float* sink, bf16_t* AO) {
    constexpr int KPT = 144, VPT = 400, L_KB = 0, L_VB = 192 * KPT, ABUF = L_VB + 64 * VPT, L_BT = 2 * ABUF, L_OST = L_BT + QH * WIN * 4, OPT = 144;
    static_assert(L_OST + 8 * 32 * OPT <= PHASE_LDS, "attention LDS");
    LAS unsigned char* lds = F.lds;
    LAS float* BT = (LAS float*)(lds + L_BT);
    const int tid = fresh_tid(), lane = tid & 63, w = __builtin_amdgcn_readfirstlane(tid >> 6), l31 = lane & 31, hh = lane >> 5;
    for (int idx = tid; idx < QH * WIN; idx += 512) { const int hq = idx >> 7, n = idx & 127; int bk;
        if (n < 16) bk = n; else { bk = 16 + (int)(__logf((float)n * (1.0f / 16.0f)) / __logf(8.0f) * 16.0f); bk = bk > 31 ? 31 : bk; }
        BT[idx] = rel_bias[bk * QH + hq] * LOG2E; }
    constexpr int NITEM = BATCH * KVH * (SEQ / 64);
    u32x4 rk[3], rvv[3]; bf16x8 qf[4];
#define AT_LOAD(it_) do { const int b_ = (it_) / (KVH * (SEQ / 64)), kvh_ = ((it_) / (SEQ / 64)) % KVH, pg_ = (it_) % (SEQ / 64); const size_t rowb_ = (size_t)b_ * SEQ; \
        _Pragma("unroll") for (int i_ = 0; i_ < 3; ++i_) { const int p_ = tid + 512 * i_, kr_ = 64 * pg_ - 128 + (p_ >> 3); \
            rk[i_] = kr_ >= 0 ? *(const u32x4*)(K2 + (rowb_ + kr_) * 256 + kvh_ * HD + (p_ & 7) * 8) : (u32x4){0u, 0u, 0u, 0u}; \
            const int blk_ = pg_ - 2 + i_; rvv[i_] = blk_ >= 0 ? *(const u32x4*)(VT2 + (((size_t)b_ * (SEQ / 64) + blk_) * 256 + kvh_ * HD + (tid >> 3)) * 64 + (tid & 7) * 8) : (u32x4){0u, 0u, 0u, 0u}; } } while (0)
#define AT_LOADQ(it_) do { const int b_ = (it_) / (KVH * (SEQ / 64)), kvh_ = ((it_) / (SEQ / 64)) % KVH, pg_ = (it_) % (SEQ / 64); const size_t rowb_ = (size_t)b_ * SEQ; \
        const int hq_ = 4 * kvh_ + (w & 3), p0_ = 64 * pg_ + 32 * (w >> 2); \
        _Pragma("unroll") for (int kk = 0; kk < 4; ++kk) qf[kk] = *(const bf16x8*)(Q2 + (rowb_ + p0_ + l31) * D + hq_ * HD + 16 * kk + 8 * hh); } while (0)
#define AT_WRITE(buf_) do { LAS unsigned char* s_ = lds + (buf_) * ABUF; \
        _Pragma("unroll") for (int i_ = 0; i_ < 3; ++i_) { const int p_ = tid + 512 * i_; *(LAS u32x4*)(s_ + L_KB + (p_ >> 3) * KPT + (p_ & 7) * 16) = rk[i_]; \
            *(LAS u32x4*)(s_ + L_VB + (tid >> 3) * VPT + i_ * 128 + (tid & 7) * 16) = rvv[i_]; } } while (0)
    int it = F.vcu, buf = 0;
    if (it < NITEM) { AT_LOAD(it); AT_LOADQ(it); AT_WRITE(0); }
    LDS_WAIT(); __syncthreads();
    for (; it < NITEM; it += F.G) {
        const int b = it / (KVH * (SEQ / 64)), kvh = (it / (SEQ / 64)) % KVH, pg = it % (SEQ / 64);
        const int hq = 4 * kvh + (w & 3), wq = w >> 2, p0 = 64 * pg + 32 * wq;
        const size_t rowb = (size_t)b * SEQ;
        const LAS unsigned char* sb = lds + buf * ABUF;
        const bool more = it + F.G < NITEM;
        f32x16 s[5];
        const int j0 = p0 >= 128 ? 0 : (128 - p0) / 32;
        const float zs = sink[hq] * LOG2E; float mx = zs;
        int ib = l31 - 4 * hh; asm volatile("" : "+v"(ib));
        const LAS float* bp = BT + hq * WIN + (ib - 31);
#pragma unroll
        for (int j = 0; j < 5; ++j) {
#pragma unroll
            for (int r = 0; r < 16; ++r) s[j][r] = bp[128 - 32 * j - ((r & 3) + 8 * (r >> 2)) + 31];
#pragma unroll
            for (int kk = 0; kk < 4; ++kk) { const bf16x8 kf = *(const LAS bf16x8*)(sb + L_KB + (32 * wq + 32 * j + l31) * KPT + (16 * kk + 8 * hh) * 2);
                s[j] = __builtin_amdgcn_mfma_f32_32x32x16_bf16(kf, qf[kk], s[j], 0, 0, 0); } }
        if (more) { AT_LOADQ(it + F.G); AT_LOAD(it + F.G); }
#pragma unroll
        for (int j = 0; j < 5; ++j) { const bool jin = j >= j0;
#pragma unroll
            for (int r = 0; r < 16; ++r) { const int cr = (r & 3) + 8 * (r >> 2);
                const bool ok = jin && (j == 0 ? ib < cr : (j == 4 ? ib >= cr : true));
                const float z = ok ? s[j][r] : -INFINITY; s[j][r] = z; mx = fmaxf(mx, z); } }
        mx = fmaxf(mx, __shfl_xor(mx, 32));
        float den = 0.f;
#pragma unroll
        for (int j = 0; j < 5; ++j)
#pragma unroll
            for (int r = 0; r < 16; ++r) { const float p = __builtin_amdgcn_exp2f(s[j][r] - mx); s[j][r] = p; den += p; }
        den += __shfl_xor(den, 32); den += __builtin_amdgcn_exp2f(zs - mx);
        const float inv = fast_rcp(den);
        f32x16 o[2]; o[0] = (f32x16){}; o[1] = (f32x16){};
#pragma unroll
        for (int j = 0; j < 5; ++j) { {
#pragma unroll
            for (int s2 = 0; s2 < 2; ++s2) { u32x4 pw; pw.x = cvt_pk_bf16(s[j][8 * s2 + 0], s[j][8 * s2 + 1]); pw.y = cvt_pk_bf16(s[j][8 * s2 + 2], s[j][8 * s2 + 3]);
                pw.z = cvt_pk_bf16(s[j][8 * s2 + 4], s[j][8 * s2 + 5]); pw.w = cvt_pk_bf16(s[j][8 * s2 + 6], s[j][8 * s2 + 7]);
#pragma unroll
                for (int dt = 0; dt < 2; ++dt) { const LAS unsigned char* vp = sb + L_VB + (32 * dt + l31) * VPT + (32 * wq + 32 * j + 16 * s2 + 4 * hh) * 2;
                    const u32x2 lo = *(const LAS u32x2*)vp, hi = *(const LAS u32x2*)(vp + 16); const u32x4 vw = {lo.x, lo.y, hi.x, hi.y};
                    o[dt] = __builtin_amdgcn_mfma_f32_32x32x16_bf16(__builtin_bit_cast(bf16x8, vw), __builtin_bit_cast(bf16x8, pw), o[dt], 0, 0, 0); } } } }
        { LAS unsigned char* ost = lds + L_OST + w * (32 * OPT);
          if (WO_FP8) { const float sc = inv * S8_AO;
#pragma unroll
              for (int dt = 0; dt < 2; ++dt)
#pragma unroll
                  for (int i = 0; i < 4; ++i) *(LAS unsigned*)(ost + l31 * OPT + (32 * dt + 8 * i + 4 * hh)) = pk4_fp8(o[dt][4 * i] * sc, o[dt][4 * i + 1] * sc, o[dt][4 * i + 2] * sc, o[dt][4 * i + 3] * sc);
              LDS_WAIT();
              unsigned char* obase = (unsigned char*)AO + (rowb + p0) * D + hq * HD + (lane & 3) * 16;
#pragma unroll
              for (int k = 0; k < 2; ++k) { const int row = (lane >> 2) + 16 * k; const u32x4 v = *(const LAS u32x4*)(ost + row * OPT + (lane & 3) * 16); *(u32x4*)(obase + (size_t)row * D) = v; } }
          else {
#pragma unroll
          for (int dt = 0; dt < 2; ++dt)
#pragma unroll
              for (int i = 0; i < 4; ++i) { u32x2 wv; wv.x = cvt_pk_bf16(o[dt][4 * i] * inv, o[dt][4 * i + 1] * inv); wv.y = cvt_pk_bf16(o[dt][4 * i + 2] * inv, o[dt][4 * i + 3] * inv);
                  *(LAS u32x2*)(ost + l31 * OPT + (32 * dt + 8 * i + 4 * hh) * 2) = wv; }
          LDS_WAIT();
          bf16_t* obase = AO + (rowb + p0) * D + hq * HD + (lane & 7) * 8;
#pragma unroll
          for (int k = 0; k < 4; ++k) { const int row = (lane >> 3) + 8 * k; const u32x4 v = *(const LAS u32x4*)(ost + row * OPT + (lane & 7) * 16); *(u32x4*)(obase + (size_t)row * D) = v; } } }
        if (more) AT_WRITE(buf ^ 1);
        LDS_WAIT(); __syncthreads();
        buf ^= 1;
    }
#undef AT_LOAD
#undef AT_LOADQ
#undef AT_WRITE
}

__device__ __forceinline__ void router_phase(Frame& F, const bf16_t* H3, const u64* rowss, const float* router, const float* gain, gu32* ctl, int* LTOK, float* LG) {
    constexpr int WP = 2064;
    LAS unsigned char* WH = F.lds;
    LAS unsigned char* WL = F.lds + 8 * WP;
    LAS float* LOGT = (LAS float*)(F.lds + 16 * WP + 256);
    LAS unsigned* CNT = (LAS unsigned*)(F.lds + 16 * WP + 256 + 8192);
    const int tid = fresh_tid(), lane = tid & 63, w = __builtin_amdgcn_readfirstlane(tid >> 6), l15 = lane & 15, kq = lane >> 4;
#pragma unroll
    for (int i = 0; i < 2; ++i) { const int k = tid + 512 * i; const f32x4 r0 = ((const f32x4*)router)[2 * k], r1 = ((const f32x4*)router)[2 * k + 1]; const float g = gain[k];
        const float v[8] = {r0[0] * g, r0[1] * g, r0[2] * g, r0[3] * g, r1[0] * g, r1[1] * g, r1[2] * g, r1[3] * g};
#pragma unroll
        for (int e = 0; e < 8; ++e) { const unsigned hb = cvt_pk_bf16_n(v[e], 0.f) & 0xffffu; const float hf = __builtin_bit_cast(float, hb << 16); const unsigned lb = cvt_pk_bf16_n(v[e] - hf, 0.f) & 0xffffu;
            *(LAS bf16_t*)(WH + e * WP + k * 2) = (bf16_t)hb; *(LAS bf16_t*)(WL + e * WP + k * 2) = (bf16_t)lb; } }
    for (int tb = F.vcu; tb < T / 256; tb += F.G) {
        if (tid < 32) CNT[tid] = 0u;
        LDS_WAIT(); __syncthreads();
        const bf16_t* arow = H3 + ((size_t)tb * 256 + w * 32 + l15) * D + 8 * kq;
        const LAS unsigned char* bh = WH + (lane & 7) * WP + kq * 16; const LAS unsigned char* bl = WL + (lane & 7) * WP + kq * 16;
        f32x4 acc0 = {}, acc1 = {};
        u32x4 a0[2][8], a1[2][8];
#define RT_LOADA(buf, ch) do { _Pragma("unroll") for (int j_ = 0; j_ < 8; ++j_) { buf[0][j_] = *(const u32x4*)(arow + ((ch) * 8 + j_) * 32); buf[1][j_] = *(const u32x4*)(arow + 16 * D + ((ch) * 8 + j_) * 32); } } while (0)
#define RT_COMP(buf, ch) do { _Pragma("unroll") for (int j_ = 0; j_ < 8; ++j_) { const bf16x8 wh_ = *(const LAS bf16x8*)(bh + ((ch) * 8 + j_) * 64), wl_ = *(const LAS bf16x8*)(bl + ((ch) * 8 + j_) * 64); \
            const bf16x8 x0_ = __builtin_bit_cast(bf16x8, buf[0][j_]), x1_ = __builtin_bit_cast(bf16x8, buf[1][j_]); \
            acc0 = __builtin_amdgcn_mfma_f32_16x16x32_bf16(x0_, wh_, acc0, 0, 0, 0); acc1 = __builtin_amdgcn_mfma_f32_16x16x32_bf16(x1_, wh_, acc1, 0, 0, 0); \
            acc0 = __builtin_amdgcn_mfma_f32_16x16x32_bf16(x0_, wl_, acc0, 0, 0, 0); acc1 = __builtin_amdgcn_mfma_f32_16x16x32_bf16(x1_, wl_, acc1, 0, 0, 0); } } while (0)
        RT_LOADA(a0, 0); RT_LOADA(a1, 1);
        RT_COMP(a0, 0); RT_LOADA(a0, 2);
        RT_COMP(a1, 1); RT_LOADA(a1, 3);
        RT_COMP(a0, 2); RT_COMP(a1, 3);
#undef RT_LOADA
#undef RT_COMP
        if (l15 < 8) {
#pragma unroll
            for (int r = 0; r < 4; ++r) { LOGT[(w * 32 + 4 * kq + r) * 8 + l15] = acc0[r]; LOGT[(w * 32 + 16 + 4 * kq + r) * 8 + l15] = acc1[r]; } }
        LDS_WAIT(); __syncthreads();
        int e1 = 0, e2 = 0, r1 = 0, r2 = 0; float g1 = 0.f, g2 = 0.f;
        if (tid < 256) { const f32x4 q0 = *(const LAS f32x4*)(LOGT + tid * 8), q1 = *(const LAS f32x4*)(LOGT + tid * 8 + 4); const float l[8] = {q0[0], q0[1], q0[2], q0[3], q1[0], q1[1], q1[2], q1[3]};
            const float r = rinv_of(rowss[(size_t)tb * 256 + tid]);
            float l1 = l[0];
#pragma unroll
            for (int e = 1; e < 8; ++e) if (l[e] > l1) { l1 = l[e]; e1 = e; }
            e2 = e1 == 0 ? 1 : 0; float l2 = -INFINITY;
#pragma unroll
            for (int e = 0; e < 8; ++e) if (e != e1 && l[e] > l2) { l2 = l[e]; e2 = e; }
            g2 = 1.0f / (1.0f + __expf((l1 - l2) * r)); g1 = 1.0f - g2;
            r1 = (int)__hip_atomic_fetch_add(&CNT[e1], 1u, __ATOMIC_RELAXED, __HIP_MEMORY_SCOPE_WORKGROUP); r2 = (int)__hip_atomic_fetch_add(&CNT[8 + e2], 1u, __ATOMIC_RELAXED, __HIP_MEMORY_SCOPE_WORKGROUP); }
        LDS_WAIT(); __syncthreads();
        if (tid < 16) CNT[16 + tid] = __hip_atomic_fetch_add(ctl + CW_MCNT + 64 * tid, CNT[tid], RLX_AGENT);
        LDS_WAIT(); __syncthreads();
        if (tid < 256) { const int tok = tb * 256 + tid; const unsigned p1 = CNT[16 + e1] + (unsigned)r1, p2 = CNT[24 + e2] + (unsigned)r2;
            LTOK[(size_t)e1 * T + p1] = tok; LG[(size_t)e1 * T + p1] = g1;
            LTOK[(size_t)(8 + e2) * T + p2] = tok; LG[(size_t)(8 + e2) * T + p2] = g2; }
        __syncthreads();
    }
}
__device__ __forceinline__ unsigned moe_counts(const gu32* ctl) {
    const int l = (int)__builtin_amdgcn_mbcnt_hi(~0u, __builtin_amdgcn_mbcnt_lo(~0u, 0u)) & 15;
    return ld_agent((const unsigned*)ctl + CW_MCNT + 64 * l);
}
__device__ __forceinline__ void moe_tiles(const gu32* ctl, int k, int* tstart  , unsigned* cnt = nullptr) {
    const unsigned cv = moe_counts(ctl); int a = 0;
#pragma unroll
    for (int e = 0; e < NE; ++e) { tstart[e] = a; const unsigned c = (unsigned)__builtin_amdgcn_readlane((int)cv, k * 8 + e); if (cnt) cnt[e] = c; a += (int)((c + 255u) >> 8); }
    tstart[NE] = a;
}
__device__ __forceinline__ void rowtable_phase(Frame& F, const gu32* ctl, const int* LTOK, const float* LG, const u64* rowss, int* RTOK, float* RG, float* RRINV, int* TILEE) {
    for (int k = 0; k < 2; ++k) { int ts[9]; unsigned cnt[8]; moe_tiles(ctl, k, ts, cnt);
        const int nrows = ts[NE] * 256;
        for (int pr = F.vcu * 512 + fresh_tid(); pr < nrows; pr += F.G * 512) { const int rt = pr >> 8; int e = 0; int st = 0; unsigned ce = cnt[0];
#pragma unroll
            for (int ee = 1; ee < NE; ++ee) if (rt >= ts[ee]) { e = ee; st = ts[ee]; ce = cnt[ee]; }
            const unsigned pos = (unsigned)(pr - st * 256); int tok = -1; float gt = 0.f, ri = 0.f;
            if (pos < ce) { tok = LTOK[(size_t)(k * 8 + e) * T + pos]; gt = LG[(size_t)(k * 8 + e) * T + pos]; ri = rinv_of(rowss[tok]) * (1.0f / (S8_H3 * S8_WGU)); gt *= 1.0f / (S8_HID * S8_WDN); }
            RTOK[k * MPAD + pr] = tok; RG[k * MPAD + pr] = gt; RRINV[k * MPAD + pr] = ri;
            if ((pr & 255) == 0) TILEE[k * 512 + rt] = e; } }
}

struct Args { Ptrs p; int ph_lo, ph_hi; };
#ifndef DBG_STAGE
#define DBG_STAGE 99
#endif
__global__ void __launch_bounds__(512, 2) fwd_kernel(Args args) {
    extern __shared__ __attribute__((aligned(16))) unsigned char lds_raw[];
    Frame F;
    F.lds = (LAS unsigned char*)lds_raw;
    F.tid = threadIdx.x; F.lane = F.tid & 63; F.wave = __builtin_amdgcn_readfirstlane(F.tid >> 6);
    F.G = gridDim.x; { const int bx = blockIdx.x; F.vcu = (F.G % 8 == 0) ? (bx % 8) * (F.G / 8) + bx / 8 : bx; }
    const Ptrs& P = args.p;
    unsigned char* ws = P.ws;
    gu32* ctl = (gu32*)(ws + WS_CTL);
    volatile LAS unsigned* MISC = (volatile LAS unsigned*)(F.lds + MISC_OFF);
    for (int u = F.tid; u < (LDS_BYTES - PHASE_LDS) / 4; u += 512) ((LAS unsigned*)(F.lds + PHASE_LDS))[u] = 0u;
    __syncthreads();
    XcdBarrier bar = xcd_barrier_post((unsigned*)(ctl + CW_BAR), MISC + 8);
    const int lo = args.ph_lo, hi = args.ph_hi;
#define IN(k) (lo <= (k) && (k) < hi)
#ifndef PROBE_SEAM
#define PROBE_SEAM -1
#endif
    volatile LAS unsigned long long* PRB = (volatile LAS unsigned long long*)(F.lds + MISC_OFF + 64);
    if (PROBE_SEAM >= 0 && fresh_tid() == 0) PRB[0] = __builtin_amdgcn_s_memrealtime();
#define SEAM(k) do { if (IN(k) && IN((k) + 1)) xcd_barrier(bar); if (PROBE_SEAM == (k) && fresh_tid() == 0) PRB[1] = __builtin_amdgcn_s_memrealtime(); } while (0)
    using namespace pg8;
    const int bid = (int)blockIdx.x;
    u64* rowss1 = (u64*)(ws + WS_ROWSS1); u64* rowss2 = (u64*)(ws + WS_ROWSS2); u64* rowss3 = (u64*)(ws + WS_ROWSS3);

    if (IN(0)) { p0_prologue(F, P); } SEAM(0);
    if (IN(1)) { Gemm g{(const bf16_t*)(ws + WS_XN), (const bf16_t*)(ws + WS_WQO), D, 0, nullptr}; StaticOrder S; S.init(T / 256, 4, F.G, bid);
        epi::EpiOG E{(bf16_t*)(ws + WS_OG1)}; gemm_phase<epi::EpiOG, StaticOrder, false>(F.lds, g, S, E, F.wave); }
    if (IN(2)) { Gemm g{(const bf16_t*)(ws + WS_WFI), (const bf16_t*)(ws + WS_XN), D, 0, nullptr}; StaticOrder S; S.init(12, T / 256, F.G, bid);
        static_assert(WS_GT == WS_Q1 + 128 * MiB && WS_VT == WS_GT + 128 * MiB, "QT|GT|VT spacing");
        epi::EpiQFI E{(unsigned short*)(ws + WS_Q1), (const float*)(ws + WS_LB)}; gemm_phase<epi::EpiQFI, StaticOrder, false>(F.lds, g, S, E, F.wave); }
    SEAM(2);
    if (IN(3)) scan_state_pass(F, P, (const unsigned short*)(ws + WS_GT), (const bf16_t*)(ws + WS_VT), (float*)(ws + WS_SST));
    SEAM(3);
    if (IN(4)) scan_output_pass(F, (const bf16_t*)(ws + WS_Q1), (const unsigned short*)(ws + WS_GT), (const bf16_t*)(ws + WS_VT), (const float*)(ws + WS_SST), (const bf16_t*)(ws + WS_OG1), P.gnorm, (bf16_t*)(ws + WS_OGATED));
    SEAM(4);
    if (IN(5)) { Gemm g{(const bf16_t*)(ws + WS_OGATED), (const bf16_t*)(ws + WS_WOUT), D, 0, nullptr}; StaticOrder S; S.init(T / 256, 4, F.G, bid);
        epi::EpiRes<2, DBG_STAGE == 1, FFN_GU_FP8 != 0> E{(const void*)(ws + WS_XN), (bf16_t*)(ws + WS_H1), P.out, rowss1, FFN_GU_FP8 ? ws + WS_H18 : nullptr, (const float*)(ws + WS_INVR0), (const float*)(ws + WS_INVG)}; gemm_phase<epi::EpiRes<2, DBG_STAGE == 1, FFN_GU_FP8 != 0>, StaticOrder, false>(F.lds, g, S, E, F.wave); }
    SEAM(5);
#if DBG_STAGE >= 2
    if (IN(6)) { Gemm g{(const bf16_t*)(ws + (FFN_GU_FP8 ? WS_H18 : WS_H1)), (const bf16_t*)(ws + WS_WGU), D, 0, nullptr}; StaticOrder S; S.init(T / 256, 2 * FF0 / 256, F.G, bid);
        epi::EpiGU<false, FFN_DOWN_FP8 != 0> E{(bf16_t*)(ws + WS_HID0), FF0, rowss1, FFN_GU_FP8 ? 1.0f / (S8_H3 * S8_WGU) : 1.0f}; gemm_phase<epi::EpiGU<false, FFN_DOWN_FP8 != 0>, StaticOrder, false, FFN_GU_FP8 != 0>(F.lds, g, S, E, F.wave); }
    SEAM(6);
    if (IN(7)) { Gemm g{(const bf16_t*)(ws + WS_HID0), (const bf16_t*)(ws + WS_WDN), FF0, 0, nullptr}; StaticOrder S; S.init(T / 256, 4, F.G, bid);
        epi::EpiRes<0, DBG_STAGE == 2, QKV_FP8 != 0> E{(const void*)(ws + WS_H1), (bf16_t*)(ws + WS_H2), P.out, rowss2, QKV_FP8 ? ws + WS_H28 : nullptr, nullptr, nullptr, FFN_DOWN_FP8 ? 1.0f / (S8_HID * S8_WDN) : 1.0f}; gemm_phase<epi::EpiRes<0, DBG_STAGE == 2, QKV_FP8 != 0>, StaticOrder, false, FFN_DOWN_FP8 != 0>(F.lds, g, S, E, F.wave); }
    SEAM(7);
#endif
#if DBG_STAGE >= 3
    if (IN(8)) { constexpr float qsc = QKV_FP8 ? 1.0f / (S8_H2 * S8_WQ) : 1.0f; const bf16_t* hsrc = (const bf16_t*)(ws + (QKV_FP8 ? WS_H28 : WS_H2));
        { Gemm g{hsrc, (const bf16_t*)(ws + WS_WQK), D, 0, nullptr}; StaticOrder S; S.init(T / 256, 5, F.G, bid);
          epi::EpiQK E{(bf16_t*)(ws + WS_Q2), (bf16_t*)(ws + WS_K2), rowss2, P.q_gain, P.k_gain, qsc}; gemm_phase<epi::EpiQK, StaticOrder, false, QKV_FP8 != 0>(F.lds, g, S, E, F.wave); }
        { Gemm g{(const bf16_t*)(ws + WS_WV), hsrc, D, 0, nullptr}; StaticOrder S; S.init(1, T / 256, F.G, bid);
          epi::EpiVT E{(bf16_t*)(ws + WS_VT2), rowss2, qsc}; gemm_phase<epi::EpiVT, StaticOrder, false, QKV_FP8 != 0>(F.lds, g, S, E, F.wave); } }
    SEAM(8);
    if (IN(9)) attn_phase(F, (const bf16_t*)(ws + WS_Q2), (const bf16_t*)(ws + WS_K2), (const bf16_t*)(ws + WS_VT2), P.rel_bias, P.sink, (bf16_t*)(ws + WS_AO));
    SEAM(9);
    if (IN(10)) { Gemm g{(const bf16_t*)(ws + WS_AO), (const bf16_t*)(ws + WS_WO), D, 0, nullptr}; StaticOrder S; S.init(T / 256, 4, F.G, bid);
        epi::EpiRes<0, false, true> E{(const void*)(ws + WS_H2), (bf16_t*)(ws + WS_H2), nullptr, rowss3, ws + WS_H38, nullptr, nullptr, WO_FP8 ? 1.0f / (S8_AO * S8_WO) : 1.0f}; gemm_phase<epi::EpiRes<0, false, true>, StaticOrder, false, WO_FP8 != 0>(F.lds, g, S, E, F.wave); }
    SEAM(10);
#endif
#if DBG_STAGE >= 4
    if (IN(11)) router_phase(F, (const bf16_t*)(ws + WS_H2), rowss3, P.router, P.ffn_norm + D, ctl, (int*)(ws + WS_LTOK), (float*)(ws + WS_LG));
    SEAM(11);
    if (IN(12)) rowtable_phase(F, ctl, (const int*)(ws + WS_LTOK), (const float*)(ws + WS_LG), rowss3, (int*)(ws + WS_RTOK), (float*)(ws + WS_RG), (float*)(ws + WS_RRINV), (int*)(ws + WS_TILEE));
    SEAM(12);
#pragma unroll
    for (int k = 0; k < 2; ++k) {
        if (IN(13 + 2 * k)) { int ts[9]; moe_tiles(ctl, k, ts);
            Gemm g{(const bf16_t*)(ws + WS_H38), (const bf16_t*)(ws + WS_MGU), D, (size_t)2 * FFE * D, (const int*)(ws + WS_RTOK) + k * MPAD};   StaticOrder S; S.init(ts[NE], 2 * FFE / 256, F.G, k == 0 ? bid : F.G - 1 - bid  , ts);
            epi::EpiGU<true> E{(bf16_t*)(ws + WS_HIDM + (size_t)k * MPAD * FFE), FFE, (const float*)(ws + WS_RRINV) + k * MPAD}; gemm_phase<epi::EpiGU<true>, StaticOrder, true, true>(F.lds, g, S, E, F.wave); }
        SEAM(13 + 2 * k);
        if (IN(14 + 2 * k)) { int ts[9]; moe_tiles(ctl, k, ts);
            Gemm g{(const bf16_t*)(ws + WS_HIDM + (size_t)k * MPAD * FFE), (const bf16_t*)(ws + WS_MDN), FFE, (size_t)D * FFE, nullptr}; StaticOrder S; S.init(ts[NE], 4, F.G, bid, ts);
            if (k == 0) { epi::EpiMoeDown<true> E{P.out, (const int*)(ws + WS_RTOK), (const float*)(ws + WS_RG), (bf16_t*)(ws + WS_H2), ws + WS_TILEE + 65536}; gemm_phase<epi::EpiMoeDown<true>, StaticOrder, false, true>(F.lds, g, S, E, F.wave); }
            else { epi::EpiMoeDown<false> E{P.out, (const int*)(ws + WS_RTOK) + MPAD, (const float*)(ws + WS_RG) + MPAD, (bf16_t*)(ws + WS_H2), ws + WS_TILEE + 65536}; gemm_phase<epi::EpiMoeDown<false>, StaticOrder, false, true>(F.lds, g, S, E, F.wave); } }
        if (k == 1) SEAM(14 + 2 * k);
    }
#endif
    if (PROBE_SEAM >= 0 && blockIdx.x == 0 && fresh_tid() == 0) { const unsigned long long tend = __builtin_amdgcn_s_memrealtime(), want = 8ull * (PRB[1] - PRB[0]);
        while (__builtin_amdgcn_s_memrealtime() - tend < want) __builtin_amdgcn_s_sleep(32); }
#undef IN
#undef SEAM
}
constexpr int N_PHASES = 17;

extern "C" void kernel_launch(void* const* d_in, const int* in_sizes, int n_in, void* d_out, int out_size, void* d_ws, size_t ws_size, hipStream_t stream) {
    static int grid = 0;
    if (grid == 0) {
        if (n_in != 22 || in_sizes[0] != T * D || out_size != T * D || ws_size < WS_END) { fprintf(stderr, "kernel_launch: unexpected shapes/workspace: n_in %d in0 %d out %d ws %zu (need %zu)\n", n_in, n_in > 0 ? in_sizes[0] : -1, out_size, ws_size, (size_t)WS_END); grid = -1; return; }
        int dev = 0, cus = 0, per_cu = 0;
        if (hipGetDevice(&dev) != hipSuccess || hipDeviceGetAttribute(&cus, hipDeviceAttributeMultiprocessorCount, dev) != hipSuccess) { fprintf(stderr, "kernel_launch: device query failed\n"); grid = -1; return; }
        if (hipFuncSetAttribute((const void*)fwd_kernel, hipFuncAttributeMaxDynamicSharedMemorySize, LDS_BYTES) != hipSuccess) { fprintf(stderr, "kernel_launch: hipFuncSetAttribute failed\n"); grid = -1; return; }
        if (hipOccupancyMaxActiveBlocksPerMultiprocessor(&per_cu, (const void*)fwd_kernel, 512, LDS_BYTES) != hipSuccess || per_cu < 1) fprintf(stderr, "kernel_launch: occupancy query reports %d blocks per CU\n", per_cu);
        (void)hipGetLastError();
        grid = cus;
    }
    if (grid < 0) return;
    if (hipMemsetAsync((char*)d_ws + WS_CTL, 0, CTL_ZERO_BYTES, stream) != hipSuccess) { fprintf(stderr, "kernel_launch: memset failed\n"); return; }
    Args a{};
    const float** pp = (const float**)&a.p;
    for (int i = 0; i < 22; ++i) pp[i] = (const float*)d_in[i];
    a.p.out = (float*)d_out; a.p.ws = (unsigned char*)d_ws;
    a.ph_lo = 0; a.ph_hi = N_PHASES;
    hipLaunchKernelGGL(fwd_kernel, dim3(grid), dim3(512), LDS_BYTES, stream, a);
    const hipError_t le = hipPeekAtLastError();
    if (le != hipSuccess) fprintf(stderr, "kernel_launch: launch failed: %s\n", hipGetErrorName(le));
}
```
